# Optimizing an MI355X kernel written in HIP

```python
import math
import jax
import jax.numpy as jnp
from jax import lax
import numpy as np

D_MODEL = 1024
BATCH = 2
SEQ = 8192
DEPTH = 4

N_MIXERS = 3
Q_BLK = 128
EPS = 1e-6
NEG = -1e30
FORCE = 1e4
NSA_HEADS = 16
NSA_DK = 64
NSA_KV = 4
NSA_REP = NSA_HEADS // NSA_KV
CMP_LEN = 32
CMP_STRIDE = 16
CMP_HID = 256
SEL_LEN = 64
SEL_TOPK = 16
WIN = 512
NSA_QW = NSA_HEADS * NSA_DK
NSA_KVW = NSA_KV * NSA_DK
NSA_IN = NSA_QW + 6 * NSA_KVW + 3 * NSA_HEADS
SB_HEADS = 16
SB_DH = D_MODEL // SB_HEADS
DIFF_HEADS = 8
DIFF_DH = D_MODEL // (2 * DIFF_HEADS)
D_FF = 2816
N_A = (DEPTH + 2) // 3
N_B = (DEPTH + 1) // 3
N_C = DEPTH // 3

kernel_name = "hybrid_nsa_stickbreak_diffattn_macaron"


def rms_norm(x, g):
    xf = x.astype(jnp.float32)
    y = xf * lax.rsqrt(jnp.mean(xf * xf, axis=-1, keepdims=True) + EPS)
    return (y * g.astype(jnp.float32)).astype(x.dtype)


def alibi_slopes(n):
    return jnp.exp2(-8.0 * jnp.arange(1, n + 1, dtype=jnp.float32) / n)


def swiglu(h, w1, w2):
    gate, up = jnp.split(h @ w1, 2, axis=-1)
    return (jax.nn.silu(gate) * up) @ w2


def sweep_blocks(fn, seq):
    out = lax.map(fn, jnp.arange(seq // Q_BLK, dtype=jnp.int32) * Q_BLK)
    out = jnp.moveaxis(out, 0, 1)
    return out.reshape(out.shape[0], seq, *out.shape[3:])


def nsa_mixer(h, w_in, cmp_pe, cmp_w1, cmp_w2, w_out):
    B, T, _ = h.shape
    f32 = jnp.float32
    bounds = [int(b) for b in np.cumsum([NSA_QW] + [NSA_KVW] * 6)]
    parts = jnp.split(h @ w_in, bounds, axis=-1)
    q = parts[0].reshape(B, T, NSA_KV, NSA_REP, NSA_DK)
    kc, vc, ks, vs, kw, vw = [p.reshape(B, T, NSA_KV, NSA_DK) for p in parts[1:7]]
    gates = jax.nn.sigmoid(parts[7].astype(f32)).reshape(B, T, NSA_KV, NSA_REP, 3)
    scale = NSA_DK ** -0.5
    slopes = alibi_slopes(NSA_HEADS).reshape(NSA_KV, NSA_REP)

    n_cmp = (T - CMP_LEN) // CMP_STRIDE + 1
    cmp_start = jnp.arange(n_cmp) * CMP_STRIDE
    tok_idx = cmp_start[:, None] + jnp.arange(CMP_LEN)[None, :]

    def compress(a, j):
        blk = a[:, tok_idx] + cmp_pe[j][None, None, :, None, :]
        blk = jnp.moveaxis(blk, 3, 2).reshape(B, n_cmp, NSA_KV, CMP_LEN * NSA_DK)
        return jax.nn.gelu(blk @ cmp_w1[j]) @ cmp_w2[j]

    k_cmp = compress(kc, 0)
    v_cmp = compress(vc, 1)
    cmp_end = cmp_start + CMP_LEN - 1

    n_sel = T // SEL_LEN
    topk = min(SEL_TOPK, n_sel)
    sel_start = jnp.arange(n_sel) * SEL_LEN
    overlap = ((cmp_start[:, None] < sel_start[None, :] + SEL_LEN)
               & (cmp_start[:, None] + CMP_LEN > sel_start[None, :])).astype(f32)
    ks_blk = jnp.moveaxis(ks.reshape(B, n_sel, SEL_LEN, NSA_KV, NSA_DK), 3, 1)
    vs_blk = jnp.moveaxis(vs.reshape(B, n_sel, SEL_LEN, NSA_KV, NSA_DK), 3, 1)
    b_i = jnp.arange(B)[:, None, None, None]
    g_i = jnp.arange(NSA_KV)[None, :, None, None]
    sel_ids = jnp.arange(n_sel)

    kw_pad = jnp.pad(kw, ((0, 0), (WIN, 0), (0, 0), (0, 0)))
    vw_pad = jnp.pad(vw, ((0, 0), (WIN, 0), (0, 0), (0, 0)))

    def block(q0):
        t = q0 + jnp.arange(Q_BLK)
        qb = lax.dynamic_slice_in_dim(q, q0, Q_BLK, axis=1)
        s = jnp.einsum('bqgrd,bngd->bgrqn', qb, k_cmp).astype(f32) * scale
        dist = (t[:, None] - cmp_end[None, :]).astype(f32)
        valid = dist >= 0
        s = jnp.where(valid, s - slopes[None, :, :, None, None] * dist, NEG)
        p_cmp = jax.nn.softmax(s, axis=-1) * valid
        o_cmp = jnp.einsum('bgrqn,bngd->bqgrd', p_cmp.astype(v_cmp.dtype), v_cmp)
        imp = jnp.einsum('bgrqn,ns->bgqs', p_cmp, overlap)
        cur = t // SEL_LEN
        forced = ((sel_ids[None, :] == 0) | (sel_ids[None, :] == cur[:, None])
                  | (sel_ids[None, :] == cur[:, None] - 1))
        imp = jnp.where(forced, imp + FORCE, imp)
        imp = jnp.where(sel_ids[None, :] <= cur[:, None], imp, NEG)
        _, idx = lax.top_k(imp, topk)
        k_g = ks_blk[b_i, g_i, idx]
        v_g = vs_blk[b_i, g_i, idx]
        pos = idx[..., None] * SEL_LEN + jnp.arange(SEL_LEN)
        dist = (t[None, None, :, None, None] - pos).astype(f32)[:, :, None]
        s = jnp.einsum('bqgrd,bgqkld->bgrqkl', qb, k_g).astype(f32) * scale
        s = jnp.where(dist >= 0, s - slopes[None, :, :, None, None, None] * dist, NEG)
        p_sel = jax.nn.softmax(s, axis=(-2, -1))
        o_sel = jnp.einsum('bgrqkl,bgqkld->bqgrd', p_sel.astype(v_g.dtype), v_g)
        kwb = lax.dynamic_slice_in_dim(kw_pad, q0, WIN + Q_BLK, axis=1)
        vwb = lax.dynamic_slice_in_dim(vw_pad, q0, WIN + Q_BLK, axis=1)
        src = q0 - WIN + jnp.arange(WIN + Q_BLK)
        d_int = t[:, None] - src[None, :]
        valid = (d_int >= 0) & (d_int < WIN) & (src[None, :] >= 0)
        s = jnp.einsum('bqgrd,bsgd->bgrqs', qb, kwb).astype(f32) * scale
        s = jnp.where(valid, s - slopes[None, :, :, None, None] * d_int.astype(f32), NEG)
        p_win = jax.nn.softmax(s, axis=-1)
        o_win = jnp.einsum('bgrqs,bsgd->bqgrd', p_win.astype(vwb.dtype), vwb)
        g = lax.dynamic_slice_in_dim(gates, q0, Q_BLK, axis=1)
        o = g[..., 0:1] * o_cmp + g[..., 1:2] * o_sel + g[..., 2:3] * o_win
        return o.reshape(B, Q_BLK, NSA_QW)

    return sweep_blocks(block, T) @ w_out


def stick_breaking_mixer(h, w_in, w_out):
    B, T, _ = h.shape
    f32 = jnp.float32
    q, k, v = [a.reshape(B, T, SB_HEADS, SB_DH) for a in jnp.split(h @ w_in, 3, axis=-1)]
    scale = SB_DH ** -0.5
    src = jnp.arange(T)

    def block(q0):
        t = q0 + jnp.arange(Q_BLK)
        qb = lax.dynamic_slice_in_dim(q, q0, Q_BLK, axis=1)
        z = jnp.einsum('bqhd,bkhd->bhqk', qb, k).astype(f32) * scale
        before = src[None, :] < t[:, None]
        log_1m = jnp.where(before, jax.nn.log_sigmoid(-z), 0.0)
        log_rem = lax.cumsum(log_1m, axis=3, reverse=True) - log_1m
        a = jnp.where(before, jnp.exp(jax.nn.log_sigmoid(z) + log_rem), 0.0)
        o = jnp.einsum('bhqk,bkhd->bqhd', a.astype(v.dtype), v)
        return o.reshape(B, Q_BLK, D_MODEL)

    return sweep_blocks(block, T) @ w_out


def diff_attention_mixer(h, w_in, lam, subln_g, w_out, layer_idx):
    B, T, _ = h.shape
    f32 = jnp.float32
    lam_init = 0.8 - 0.6 * math.exp(-0.3 * layer_idx)
    lam_f = lam.astype(f32)
    lam_full = jnp.exp(jnp.sum(lam_f[0] * lam_f[1])) - jnp.exp(jnp.sum(lam_f[2] * lam_f[3])) + lam_init
    qa, ka, va = jnp.split(h @ w_in, 3, axis=-1)
    q = qa.reshape(B, T, DIFF_HEADS, 2, DIFF_DH)
    k = ka.reshape(B, T, DIFF_HEADS, 2, DIFF_DH)
    v = va.reshape(B, T, DIFF_HEADS, 2 * DIFF_DH)
    scale = DIFF_DH ** -0.5
    slopes = alibi_slopes(DIFF_HEADS)
    src = jnp.arange(T)

    def block(q0):
        t = q0 + jnp.arange(Q_BLK)
        qb = lax.dynamic_slice_in_dim(q, q0, Q_BLK, axis=1)
        dist = (t[:, None] - src[None, :]).astype(f32)
        s = jnp.einsum('bqhmd,bkhmd->bhmqk', qb, k).astype(f32) * scale
        s = jnp.where(dist >= 0, s - slopes[None, :, None, None, None] * dist, NEG)
        p = jax.nn.softmax(s, axis=-1)
        a = p[:, :, 0] - lam_full * p[:, :, 1]
        o = jnp.einsum('bhqk,bkhe->bqhe', a.astype(v.dtype), v)
        o = rms_norm(o, subln_g) * (1.0 - lam_init)
        return o.reshape(B, Q_BLK, D_MODEL)

    return sweep_blocks(block, T) @ w_out


def setup_inputs(seed: int = 0) -> dict:
    key = jax.random.key(seed)
    ks = jax.random.split(key, 18)

    def nrm(k, shape, s):
        return s * jax.random.normal(k, shape, jnp.float32)

    return {
        'x': nrm(ks[0], (BATCH, SEQ, D_MODEL), 1.0),
        'c': nrm(ks[1], (BATCH, D_MODEL), 1.0),
        'ada_w': nrm(ks[2], (DEPTH, D_MODEL, 9 * D_MODEL), 0.5 * D_MODEL ** -0.5),
        'ada_b': nrm(ks[3], (DEPTH, 9 * D_MODEL), 0.02),
        'norm_g': 1.0 + nrm(ks[4], (DEPTH, 6, D_MODEL), 0.05),
        'ffn_w1': nrm(ks[5], (DEPTH, 2, D_MODEL, 2 * D_FF), D_MODEL ** -0.5),
        'ffn_w2': nrm(ks[6], (DEPTH, 2, D_FF, D_MODEL), D_FF ** -0.5),
        'nsa_w_in': nrm(ks[7], (N_A, D_MODEL, NSA_IN), D_MODEL ** -0.5),
        'nsa_cmp_pe': nrm(ks[8], (N_A, 2, CMP_LEN, NSA_DK), 0.1),
        'nsa_cmp_w1': nrm(ks[9], (N_A, 2, CMP_LEN * NSA_DK, CMP_HID), (CMP_LEN * NSA_DK) ** -0.5),
        'nsa_cmp_w2': nrm(ks[10], (N_A, 2, CMP_HID, NSA_DK), CMP_HID ** -0.5),
        'nsa_w_out': nrm(ks[11], (N_A, NSA_QW, D_MODEL), NSA_QW ** -0.5),
        'sb_w_in': nrm(ks[12], (N_B, D_MODEL, 3 * D_MODEL), D_MODEL ** -0.5),
        'sb_w_out': nrm(ks[13], (N_B, D_MODEL, D_MODEL), D_MODEL ** -0.5),
        'diff_w_in': nrm(ks[14], (N_C, D_MODEL, 3 * D_MODEL), D_MODEL ** -0.5),
        'diff_lam': nrm(ks[15], (N_C, 4, DIFF_DH), 0.1),
        'diff_subln_g': 1.0 + nrm(ks[16], (N_C, 2 * DIFF_DH), 0.05),
        'diff_w_out': nrm(ks[17], (N_C, D_MODEL, D_MODEL), D_MODEL ** -0.5),
    }


def reference(x, c, ada_w, ada_b, norm_g, ffn_w1, ffn_w2, nsa_w_in, nsa_cmp_pe, nsa_cmp_w1, nsa_cmp_w2,
              nsa_w_out, sb_w_in, sb_w_out, diff_w_in, diff_lam, diff_subln_g, diff_w_out):
    B, T, D = x.shape
    cond = jax.nn.silu(c)
    for i in range(DEPTH):
        mod = (cond @ ada_w[i] + ada_b[i]).reshape(B, 3, 3, D)

        def sublayer(x, sidx, fn, res_w):
            shift = mod[:, sidx, 0][:, None, :]
            scl = mod[:, sidx, 1][:, None, :]
            gate = mod[:, sidx, 2][:, None, :]
            hh = rms_norm(x, norm_g[i, 2 * sidx]) * (1.0 + scl) + shift
            return x + res_w * gate * rms_norm(fn(hh), norm_g[i, 2 * sidx + 1])

        x = sublayer(x, 0, lambda hh: swiglu(hh, ffn_w1[i, 0], ffn_w2[i, 0]), 0.5)
        kind, j = i % N_MIXERS, i // N_MIXERS
        if kind == 0:
            mixer = lambda hh: nsa_mixer(hh, nsa_w_in[j], nsa_cmp_pe[j], nsa_cmp_w1[j], nsa_cmp_w2[j], nsa_w_out[j])
        elif kind == 1:
            mixer = lambda hh: stick_breaking_mixer(hh, sb_w_in[j], sb_w_out[j])
        else:
            mixer = lambda hh: diff_attention_mixer(hh, diff_w_in[j], diff_lam[j], diff_subln_g[j], diff_w_out[j], i)
        x = sublayer(x, 1, mixer, 1.0)
        x = sublayer(x, 2, lambda hh: swiglu(hh, ffn_w1[i, 1], ffn_w2[i, 1]), 0.5)
    return x
```

```cpp
#include <hip/hip_runtime.h>
#include <hip/hip_cooperative_groups.h>
#include <cstdio>
#include <cstdint>
namespace cg = cooperative_groups;
namespace pg8 {
#define PG8_LAS __attribute__((address_space(3)))
typedef unsigned short bf16_t;
typedef short bf16x8 __attribute__((ext_vector_type(8)));
typedef float f32x4 __attribute__((ext_vector_type(4)));
typedef unsigned u32x4 __attribute__((ext_vector_type(4)));
constexpr int BM = 256, BK = 64, HALF = 128, HTB = HALF * BK * 2  , STAGE_BYTES = 8 * HTB, NXCD = 8, WGM = 8;

__host__ __device__ __forceinline__ int lds_byte(int r, int c) { const int st = (r >> 4) * 2 + (c >> 5), rr = r & 15, cc = c & 31, ob = rr * 64 + cc * 2; return st * 1024 + (ob ^ (((ob >> 9) & 1) << 5)); }
__host__ __device__ __forceinline__ void stage_rc(int b, int& R, int& C) { const int st = b / 1024, sb = b % 1024, swz = sb ^ (((sb >> 9) & 1) << 5); R = (st >> 1) * 16 + swz / 64; C = (st & 1) * 32 + (swz % 64) / 2; }
__host__ __device__ __forceinline__ int perm32(int rho) { const int n = rho >> 4, i = rho & 15; return 8 * (i >> 2) + 4 * n + (i & 3); }

struct Unit { int pm, pn; };
struct Gemm { const bf16_t* A; const bf16_t* Bt; int M, N, K; };

struct StaticOrder {
    int nM, nN, nwg, G, c;
    __host__ __device__ void init(int M, int N, int G_, int c_) { nM = M / BM; nN = N / BM; nwg = nM * nN; G = G_; c = c_; }
    __host__ __device__ bool next(int i, Unit& u) const {
        const long L = (long)i * G + c; if (L >= nwg) return false;
        int wgid = (int)L; { const int q = nwg / NXCD, r = nwg % NXCD, xcd = wgid % NXCD, off = wgid / NXCD; wgid = (xcd < r ? xcd * (q + 1) : r * (q + 1) + (xcd - r) * q) + off; }
        const int nig = WGM * nN, gid = wgid / nig, fm = gid * WGM, gsz = (nM - fm) < WGM ? (nM - fm) : WGM;
        u.pm = fm + ((wgid % nig) % gsz); u.pn = (wgid % nig) / gsz; return true;
    }
    __device__ __forceinline__ void a_ready(const Unit&) const {}
    __device__ __forceinline__ void done(const Unit&) const {}
};

__device__ __forceinline__ unsigned cvt_pk_bf16(float lo, float hi) { unsigned r; asm volatile("v_cvt_pk_bf16_f32 %0, %1, %2" : "=v"(r) : "v"(lo), "v"(hi)); return r; }
typedef float f32x2 __attribute__((ext_vector_type(2)));
typedef _Float16 f16x2 __attribute__((ext_vector_type(2)));
__device__ __forceinline__ unsigned cvt_pk_f16(float lo, float hi) { const f16x2 h = {(_Float16)lo, (_Float16)hi}; return __builtin_bit_cast(unsigned, h); }
__device__ __forceinline__ float f16lo(unsigned w) { return (float)__builtin_bit_cast(f16x2, w)[0]; }
__device__ __forceinline__ float f16hi(unsigned w) { return (float)__builtin_bit_cast(f16x2, w)[1]; }
template <class Epi, class Sched, bool ALIGN_EPI = false, bool SP2 = false>
__device__ __forceinline__ void gemm_phase(PG8_LAS unsigned char* lds, const Gemm g, const Sched& S, const Epi& E) {
    int tid_ = threadIdx.x; asm volatile("" : "+v"(tid_)); const int tid = tid_, wid = __builtin_amdgcn_readfirstlane(tid >> 6), lane = tid & 63, wr = wid >> 2, wc = wid & 3, fr = lane & 15, fq = lane >> 4;
    const int K = g.K, nt = K / BK;
    unsigned voffA[2], voffB[2];
#pragma unroll
    for (int i = 0; i < 2; ++i) { int R, C; stage_rc(tid * 16 + i * 8192, R, C); const int Rb = Epi::PERM ? ((R & ~31) + perm32(R & 31)) : R;
        voffA[i] = (unsigned)(R * K + C) * 2u; voffB[i] = (unsigned)(Rb * K + C) * 2u; }
    const size_t kstep = (size_t)(BK * 2);
    const size_t hstep = (size_t)HALF * K * 2;
    const size_t tstep = 2 * hstep;
    const unsigned ldsw = (unsigned)wid * 1024u;
    const int aoff = lds_byte(wr * 64 + fr, fq * 8), boff = lds_byte(wc * 32 + fr, fq * 8);
#define PG8_SA(b, h) (((b) * 2 + (h)) * HTB)
#define PG8_SB(b, h) ((4 + (b) * 2 + (h)) * HTB)
#define PG8_STAGE(bufoff, gbase, voff) do { _Pragma("unroll") for (int _i = 0; _i < 2; ++_i) \
        __builtin_amdgcn_global_load_lds((const unsigned*)((const char*)(gbase) + (voff)[_i]), (PG8_LAS unsigned*)(lds + (bufoff) + ldsw + _i * 8192), 16, 0, 0); } while (0)
#define PG8_LDA(dst, b, h) do { _Pragma("unroll") for (int m = 0; m < 4; ++m) _Pragma("unroll") for (int k = 0; k < 2; ++k) dst[m][k] = *(const PG8_LAS bf16x8*)(lds + PG8_SA(b, h) + aoff + m * 2048 + k * 1024); } while (0)
#define PG8_LDB(dst, b, h) do { _Pragma("unroll") for (int n = 0; n < 2; ++n) _Pragma("unroll") for (int k = 0; k < 2; ++k) dst[n][k] = *(const PG8_LAS bf16x8*)(lds + PG8_SB(b, h) + boff + n * 2048 + k * 1024); } while (0)
#define PG8_MMA(ai, bj, At, Bt) do { __builtin_amdgcn_s_setprio(1); _Pragma("unroll") for (int m = 0; m < 4; ++m) _Pragma("unroll") for (int n = 0; n < 2; ++n) _Pragma("unroll") for (int k = 0; k < 2; ++k) \
        acc[ai][bj][m][n] = __builtin_amdgcn_mfma_f32_16x16x32_bf16(Bt[n][k], At[m][k], acc[ai][bj][m][n], 0, 0, 0); __builtin_amdgcn_s_setprio(0); } while (0)
#define PG8_WAIT_V(n) asm volatile("s_waitcnt vmcnt(" #n ")" ::: "memory")
#define PG8_WAIT_L(n) asm volatile("s_waitcnt lgkmcnt(" #n ")" ::: "memory")
#define PG8_BAR __builtin_amdgcn_s_barrier()
#define PG8_SCHED __builtin_amdgcn_sched_barrier(0)
    Unit cur, nxt; int ui = 0;
    if (!S.next(0, cur)) return;
    f32x4 acc[2][2][4][2];
#pragma unroll
    for (int a = 0; a < 2; ++a)
#pragma unroll
        for (int b = 0; b < 2; ++b)
#pragma unroll
            for (int m = 0; m < 4; ++m)
#pragma unroll
                for (int n = 0; n < 2; ++n) acc[a][b][m][n] = (f32x4){0.f, 0.f, 0.f, 0.f};
    bf16x8 At[4][2], B0[2][2], B1[2][2];
    const char* cA = (const char*)g.A + (size_t)cur.pm * tstep; const char* cB = (const char*)g.Bt + (size_t)cur.pn * tstep;
    S.a_ready(cur);
    if constexpr (SP2) {
        PG8_STAGE(PG8_SB(0, 0), cB, voffB); PG8_STAGE(PG8_SB(0, 1), cB + hstep, voffB); PG8_STAGE(PG8_SA(0, 0), cA, voffA); PG8_STAGE(PG8_SA(0, 1), cA + hstep, voffA);
        if (wr == 1) PG8_BAR;
        PG8_WAIT_V(2); PG8_BAR;
        PG8_STAGE(PG8_SB(1, 0), cB + kstep, voffB); PG8_STAGE(PG8_SA(1, 0), cA + kstep, voffA); PG8_STAGE(PG8_SB(1, 1), cB + hstep + kstep, voffB);
        PG8_WAIT_V(6); PG8_BAR;
    } else {
        PG8_STAGE(PG8_SB(0, 0), cB, voffB); PG8_STAGE(PG8_SA(0, 0), cA, voffA); PG8_STAGE(PG8_SB(0, 1), cB + hstep, voffB); PG8_STAGE(PG8_SA(0, 1), cA + hstep, voffA);
        if (wr == 1) PG8_BAR;
        PG8_WAIT_V(4); PG8_BAR;
        PG8_STAGE(PG8_SB(1, 0), cB + kstep, voffB); PG8_STAGE(PG8_SA(1, 0), cA + kstep, voffA); PG8_STAGE(PG8_SB(1, 1), cB + hstep + kstep, voffB);
        PG8_WAIT_V(6); PG8_BAR;
    }
    for (;;) {
        const bool has_next = S.next(ui + 1, nxt);
        const char* nA = has_next ? (const char*)g.A + (size_t)nxt.pm * tstep : cA; const char* nB = has_next ? (const char*)g.Bt + (size_t)nxt.pn * tstep : cB;
        for (int t = 0; t < nt; t += 2) {
            const bool last = (t == nt - 2);
            const char* a1 = cA + (size_t)(t + 1) * kstep;
            const char* a2 = last ? nA : cA + (size_t)(t + 2) * kstep; const char* b2 = last ? nB : cB + (size_t)(t + 2) * kstep;
            const char* a3 = a2 + kstep; const char* b3 = b2 + kstep;
            if (last && has_next) S.a_ready(nxt);
            if constexpr (SP2) {
            PG8_LDB(B0, 0, 0); PG8_LDB(B1, 0, 1); PG8_SCHED; PG8_LDA(At, 0, 0); PG8_STAGE(PG8_SA(1, 1), a1 + hstep, voffA);
            PG8_WAIT_V(8); PG8_WAIT_L(0); PG8_BAR; PG8_MMA(0, 0, At, B0); PG8_MMA(0, 1, At, B1); PG8_BAR; PG8_SCHED;
            PG8_LDA(At, 0, 1); PG8_STAGE(PG8_SB(0, 0), b2, voffB); PG8_STAGE(PG8_SB(0, 1), b2 + hstep, voffB); PG8_STAGE(PG8_SA(0, 0), a2, voffA);
            PG8_WAIT_V(8); PG8_WAIT_L(0); PG8_BAR; PG8_MMA(1, 0, At, B0); PG8_MMA(1, 1, At, B1); PG8_BAR; PG8_SCHED;
            PG8_LDB(B0, 1, 0); PG8_LDB(B1, 1, 1); PG8_SCHED; PG8_LDA(At, 1, 0); PG8_STAGE(PG8_SA(0, 1), a2 + hstep, voffA);
            PG8_WAIT_V(8); PG8_WAIT_L(0); PG8_BAR; PG8_MMA(0, 0, At, B0); PG8_MMA(0, 1, At, B1); PG8_BAR; PG8_SCHED;
            PG8_LDA(At, 1, 1); PG8_STAGE(PG8_SB(1, 0), b3, voffB); PG8_STAGE(PG8_SB(1, 1), b3 + hstep, voffB); PG8_STAGE(PG8_SA(1, 0), a3, voffA);
            PG8_WAIT_V(8); PG8_WAIT_L(0); PG8_BAR; PG8_MMA(1, 0, At, B0); PG8_MMA(1, 1, At, B1); PG8_BAR; PG8_SCHED;
            } else {
            PG8_LDB(B0, 0, 0); PG8_SCHED; PG8_LDA(At, 0, 0); PG8_STAGE(PG8_SA(1, 1), a1 + hstep, voffA);
            PG8_WAIT_L(8); PG8_BAR; PG8_WAIT_L(0); PG8_MMA(0, 0, At, B0); PG8_BAR; PG8_SCHED;
            PG8_LDB(B1, 0, 1); PG8_STAGE(PG8_SB(0, 0), b2, voffB);
            PG8_BAR; PG8_WAIT_L(0); PG8_MMA(0, 1, At, B1); PG8_BAR;
            PG8_LDA(At, 0, 1); PG8_STAGE(PG8_SA(0, 0), a2, voffA);
            PG8_BAR; PG8_WAIT_L(0); PG8_MMA(1, 0, At, B0); PG8_BAR; PG8_SCHED;
            PG8_STAGE(PG8_SB(0, 1), b2 + hstep, voffB);
            PG8_WAIT_V(6); PG8_BAR; PG8_MMA(1, 1, At, B1); PG8_BAR;
            PG8_LDB(B0, 1, 0); PG8_SCHED; PG8_LDA(At, 1, 0); PG8_STAGE(PG8_SA(0, 1), a2 + hstep, voffA);
            PG8_WAIT_L(8); PG8_BAR; PG8_WAIT_L(0); PG8_MMA(0, 0, At, B0); PG8_BAR; PG8_SCHED;
            PG8_LDB(B1, 1, 1); PG8_STAGE(PG8_SB(1, 0), b3, voffB);
            PG8_BAR; PG8_WAIT_L(0); PG8_MMA(0, 1, At, B1); PG8_BAR;
            PG8_LDA(At, 1, 1); PG8_STAGE(PG8_SA(1, 0), a3, voffA);
            PG8_BAR; PG8_WAIT_L(0); PG8_MMA(1, 0, At, B0); PG8_BAR; PG8_SCHED;
            PG8_STAGE(PG8_SB(1, 1), b3 + hstep, voffB);
            PG8_WAIT_V(6); PG8_BAR; PG8_MMA(1, 1, At, B1); PG8_BAR;
            }
        }
        if constexpr (ALIGN_EPI) { if (wr == 0) PG8_BAR; }
        if constexpr (!Epi::AFTER_DRAIN) { E(acc, cur, wr, wc, fr, fq); S.done(cur); }
        if (!has_next) break;
#pragma unroll
        for (int a = 0; a < 2; ++a)
#pragma unroll
            for (int b = 0; b < 2; ++b)
#pragma unroll
                for (int m = 0; m < 4; ++m)
#pragma unroll
                    for (int n = 0; n < 2; ++n) acc[a][b][m][n] = (f32x4){0.f, 0.f, 0.f, 0.f};
        cur = nxt; cA = nA; cB = nB; ++ui;
        if constexpr (ALIGN_EPI) { if (wr == 1) PG8_BAR; }
    }
    PG8_WAIT_V(0);
    if constexpr (!ALIGN_EPI) { if (wr == 0) PG8_BAR; }
    PG8_BAR;
    if constexpr (Epi::AFTER_DRAIN) { E.fused(acc, cur, wr, wc, fr, fq, lds, wid, lane); S.done(cur); }
#undef PG8_SA
#undef PG8_SB
#undef PG8_STAGE
#undef PG8_LDA
#undef PG8_LDB
#undef PG8_MMA
#undef PG8_WAIT_V
#undef PG8_WAIT_L
#undef PG8_BAR
#undef PG8_SCHED
}
}
namespace pg8 {
typedef unsigned u32x4e __attribute__((ext_vector_type(4)));
struct EpiSwiglu {
    static constexpr bool PERM = true, AFTER_DRAIN = false;
    bf16_t* H; int ldc;
    __device__ __forceinline__ void operator()(const f32x4 (&acc)[2][2][4][2], const Unit& u, int wr, int wc, int fr, int fq) const {
        const int row0 = u.pm * BM + wr * 64 + fr, col0 = u.pn * HALF + wc * 32 + 8 * fq;
#pragma unroll
        for (int ai = 0; ai < 2; ++ai)
#pragma unroll
            for (int m = 0; m < 4; ++m) {
                float g8[8], u8[8], v[8];
#pragma unroll
                for (int n = 0; n < 2; ++n)
#pragma unroll
                    for (int j = 0; j < 4; ++j) { g8[4 * n + j] = acc[ai][0][m][n][j]; u8[4 * n + j] = acc[ai][1][m][n][j]; }
#pragma unroll
                for (int e = 0; e < 8; ++e) v[e] = __builtin_amdgcn_exp2f(-1.4426950408889634f * g8[e]);
#pragma unroll
                for (int e = 0; e < 8; ++e) v[e] = __builtin_amdgcn_rcpf(1.0f + v[e]);
#pragma unroll
                for (int e = 0; e < 8; ++e) v[e] = (g8[e] * u8[e]) * v[e];
                u32x4e w; w.x = cvt_pk_bf16(v[0], v[1]); w.y = cvt_pk_bf16(v[2], v[3]); w.z = cvt_pk_bf16(v[4], v[5]); w.w = cvt_pk_bf16(v[6], v[7]);
                *(u32x4e*)(H + (size_t)(row0 + ai * HALF + m * 16) * ldc + col0) = w;
            }
    }
};
struct EpiBf16 {
    static constexpr bool PERM = true, AFTER_DRAIN = false;
    bf16_t* O; int ldc; int qcols; float qscale;
    __device__ __forceinline__ void operator()(const f32x4 (&acc)[2][2][4][2], const Unit& u, int wr, int wc, int fr, int fq) const {
        const int row0 = u.pm * BM + wr * 64 + fr, col0 = u.pn * BM + wc * 32 + 8 * fq;
        const float sc = (u.pn * BM < qcols) ? qscale : 1.0f;
#pragma unroll
        for (int ai = 0; ai < 2; ++ai)
#pragma unroll
            for (int m = 0; m < 4; ++m)
#pragma unroll
                for (int bj = 0; bj < 2; ++bj) {
                    const f32x4 v0 = acc[ai][bj][m][0] * sc, v1 = acc[ai][bj][m][1] * sc;
                    u32x4e w; w.x = cvt_pk_bf16(v0[0], v0[1]); w.y = cvt_pk_bf16(v0[2], v0[3]); w.z = cvt_pk_bf16(v1[0], v1[1]); w.w = cvt_pk_bf16(v1[2], v1[3]);
                    *(u32x4e*)(O + (size_t)(row0 + ai * HALF + m * 16) * ldc + col0 + bj * HALF) = w;
                }
    }
};
struct EpiF32 {
    static constexpr bool PERM = true, AFTER_DRAIN = false;
    float* Y; int ldc;
    __device__ __forceinline__ void operator()(const f32x4 (&acc)[2][2][4][2], const Unit& u, int wr, int wc, int fr, int fq) const {
        const int row0 = u.pm * BM + wr * 64 + fr, col0 = u.pn * BM + wc * 32 + 8 * fq;
#pragma unroll
        for (int ai = 0; ai < 2; ++ai)
#pragma unroll
            for (int m = 0; m < 4; ++m)
#pragma unroll
                for (int bj = 0; bj < 2; ++bj) {
                    float* p = Y + (size_t)(row0 + ai * HALF + m * 16) * ldc + col0 + bj * HALF;
                    *(f32x4*)p = acc[ai][bj][m][0]; *(f32x4*)(p + 4) = acc[ai][bj][m][1];
                }
    }
};
__device__ __forceinline__ void panel_rstd(const f32x4 (&v)[2][2][4][2], const Unit& u, int wr, int wc, int fr, int fq, PG8_LAS unsigned char* lds, int wid, int lane,
                                           float* xslots, unsigned* cnt, unsigned want, float eps) {
    PG8_LAS float* P = (PG8_LAS float*)lds;
    PG8_LAS float* S = (PG8_LAS float*)(lds + 4096);
#pragma unroll
    for (int ai = 0; ai < 2; ++ai)
#pragma unroll
        for (int m = 0; m < 4; ++m) {
            float s = 0.f;
#pragma unroll
            for (int bj = 0; bj < 2; ++bj)
#pragma unroll
                for (int n = 0; n < 2; ++n) { const f32x4 x = v[ai][bj][m][n]; s += (x[0] * x[0] + x[1] * x[1]) + (x[2] * x[2] + x[3] * x[3]); }
            s += __shfl_xor(s, 16); s += __shfl_xor(s, 32);
            if (fq == 0) P[(ai * HALF + wr * 64 + m * 16 + fr) * 4 + wc] = s;
        }
    asm volatile("s_waitcnt lgkmcnt(0)" ::: "memory"); __builtin_amdgcn_s_barrier(); asm volatile("" ::: "memory");
    const int row = wid * 32 + (lane & 31);
    if (lane < 32) {
        const float t = (P[row * 4 + 0] + P[row * 4 + 1]) + (P[row * 4 + 2] + P[row * 4 + 3]);
        __hip_atomic_store(xslots + ((size_t)(u.pm * BM + row) * 4 + u.pn), t, __ATOMIC_RELAXED, __HIP_MEMORY_SCOPE_AGENT);
    }
    asm volatile("s_waitcnt vmcnt(0)" ::: "memory");
    if (lane == 0) __hip_atomic_fetch_add(cnt + 64 * u.pm, 1u, __ATOMIC_RELAXED, __HIP_MEMORY_SCOPE_AGENT);
    if (wid == 0) {
        while ((unsigned)__builtin_amdgcn_readfirstlane(__hip_atomic_load(cnt + 64 * u.pm, __ATOMIC_RELAXED, __HIP_MEMORY_SCOPE_AGENT)) < want) __builtin_amdgcn_s_sleep(2);
        __builtin_amdgcn_fence(__ATOMIC_ACQUIRE, "agent");
    }
    asm volatile("s_waitcnt vmcnt(0) lgkmcnt(0)" ::: "memory"); __builtin_amdgcn_s_barrier(); asm volatile("" ::: "memory");
    if (lane < 32) {
        const float* slot = xslots + (size_t)(u.pm * BM + row) * 4;
        const float t = (__hip_atomic_load(slot + 0, __ATOMIC_RELAXED, __HIP_MEMORY_SCOPE_AGENT) + __hip_atomic_load(slot + 1, __ATOMIC_RELAXED, __HIP_MEMORY_SCOPE_AGENT)) +
                        (__hip_atomic_load(slot + 2, __ATOMIC_RELAXED, __HIP_MEMORY_SCOPE_AGENT) + __hip_atomic_load(slot + 3, __ATOMIC_RELAXED, __HIP_MEMORY_SCOPE_AGENT));
        S[row] = 1.0f / sqrtf(t * (1.0f / 1024.0f) + eps);
    }
    asm volatile("s_waitcnt lgkmcnt(0)" ::: "memory"); __builtin_amdgcn_s_barrier(); asm volatile("" ::: "memory");
}
struct EpiNormResNorm {
    static constexpr bool PERM = true, AFTER_DRAIN = true;
    bf16_t* X; float* XF; bf16_t* HH;
    const float* gate; const float* gpost; float res_w;
    const float* shift; const float* gpre;
    float* xbuf; unsigned* cnt; unsigned want1;
    __device__ __forceinline__ void fused(f32x4 (&acc)[2][2][4][2], const Unit& u, int wr, int wc, int fr, int fq, PG8_LAS unsigned char* lds, int wid, int lane) const {
        typedef unsigned u32x4v __attribute__((ext_vector_type(4)));
        const PG8_LAS float* S = (const PG8_LAS float*)(lds + 4096);
        const int col0 = u.pn * BM + wc * 32 + 8 * fq;
        const int b = (u.pm * BM) / 8192;
        bf16_t* X = this->X; float* XF = this->XF; bf16_t* HH = this->HH; const float* gate = this->gate; const float* gpost = this->gpost; float res_w = this->res_w;
        const float* shift = this->shift; const float* gpre = this->gpre; float* xbuf = this->xbuf; unsigned* cnt = this->cnt; unsigned want1 = this->want1;
        asm volatile("" : "+s"(X), "+s"(XF), "+s"(HH), "+s"(gate), "+s"(gpost), "+s"(res_w)); asm volatile("" : "+s"(shift), "+s"(gpre), "+s"(xbuf), "+s"(cnt), "+s"(want1));
        u32x4v pre[2][4][2];
#pragma unroll
        for (int ai = 0; ai < 2; ++ai)
#pragma unroll
            for (int m = 0; m < 4; ++m)
#pragma unroll
                for (int bj = 0; bj < 2; ++bj) pre[ai][m][bj] = *(const u32x4v*)(X + (size_t)(u.pm * BM + ai * HALF + wr * 64 + m * 16 + fr) * 1024 + col0 + bj * HALF);
        panel_rstd(acc, u, wr, wc, fr, fq, lds, wid, lane, xbuf, cnt, want1, 1e-6f);
#pragma unroll
        for (int bj = 0; bj < 2; ++bj)
#pragma unroll
            for (int n = 0; n < 2; ++n) {
                const int c = col0 + bj * HALF + n * 4;
                const f32x4 gg = *(const f32x4*)(gate + (size_t)b * 9216 + c) * *(const f32x4*)(gpost + c) * res_w;
#pragma unroll
                for (int ai = 0; ai < 2; ++ai)
#pragma unroll
                    for (int m = 0; m < 4; ++m) { const int r = ai * HALF + wr * 64 + m * 16 + fr;
                        const unsigned w0 = n ? pre[ai][m][bj].z : pre[ai][m][bj].x, w1 = n ? pre[ai][m][bj].w : pre[ai][m][bj].y;
                        const f32x4 xv = {f16lo(w0), f16hi(w0), f16lo(w1), f16hi(w1)};
                        acc[ai][bj][m][n] = xv + gg * (acc[ai][bj][m][n] * S[r]); }
                asm volatile("" ::: "memory");
            }
        if (HH) panel_rstd(acc, u, wr, wc, fr, fq, lds, wid, lane, xbuf + (size_t)16384 * 4, cnt, want1 + 32u, 1e-6f);
#pragma unroll
        for (int bj = 0; bj < 2; ++bj) {
            const int c = col0 + bj * HALF;
            f32x4 sh[2], sg[2];
#pragma unroll
            for (int n = 0; n < 2; ++n) { sh[n] = (f32x4){0.f, 0.f, 0.f, 0.f}; sg[n] = sh[n];
                if (HH) { sh[n] = *(const f32x4*)(shift + (size_t)b * 9216 + c + 4 * n); sg[n] = (*(const f32x4*)(shift + (size_t)b * 9216 + 1024 + c + 4 * n) + 1.0f) * *(const f32x4*)(gpre + c + 4 * n); } }
#pragma unroll
            for (int ai = 0; ai < 2; ++ai)
#pragma unroll
                for (int m = 0; m < 4; ++m) { const int r = ai * HALF + wr * 64 + m * 16 + fr; const size_t off = (size_t)(u.pm * BM + r) * 1024 + c;
                    const f32x4 x0 = acc[ai][bj][m][0], x1 = acc[ai][bj][m][1];
                    if (XF) { *(f32x4*)(XF + off) = x0; *(f32x4*)(XF + off + 4) = x1; }
                    else { u32x4v w; w.x = cvt_pk_f16(x0[0], x0[1]); w.y = cvt_pk_f16(x0[2], x0[3]); w.z = cvt_pk_f16(x1[0], x1[1]); w.w = cvt_pk_f16(x1[2], x1[3]); *(u32x4v*)(X + off) = w; }
                    if (HH) { const float rs = S[r]; const f32x4 o0 = x0 * rs * sg[0] + sh[0], o1 = x1 * rs * sg[1] + sh[1];
                        u32x4v w; w.x = cvt_pk_bf16(o0[0], o0[1]); w.y = cvt_pk_bf16(o0[2], o0[3]); w.z = cvt_pk_bf16(o1[0], o1[1]); w.w = cvt_pk_bf16(o1[2], o1[3]); *(u32x4v*)(HH + off) = w; } }
            asm volatile("" ::: "memory");
        }
    }
};
}
constexpr int BATCH = 2, T = 8192, D = 1024, M = BATCH * T, DFF = 2816, DEPTH = 4;
constexpr int NSA_PITCH = 2816;
constexpr int QK_PITCH = 2048 + 64;
constexpr int VT_PITCH = 16384 + 64;
constexpr float EPS = 1e-6f;
constexpr float LOG2E = 1.4426950408889634f;
constexpr float QSCALE = 0.125f * LOG2E;
constexpr float NEGB = -1e30f;
constexpr int NWAVES = 8;

constexpr size_t MiB = 1u << 20;
constexpr size_t WS_MOD = 0;
constexpr size_t WS_CMPB = 512 * 1024;
constexpr size_t WS_ZERO_BYTES = 1 * MiB;
constexpr size_t WS_W1T = 1 * MiB;
constexpr size_t WS_W2T = 89 * MiB;
constexpr size_t WS_NSAIN = 133 * MiB;
constexpr size_t WS_NSAOUT = 144 * MiB;
constexpr size_t WS_CMPW1 = 148 * MiB;
constexpr size_t WS_SBIN = 152 * MiB;
constexpr size_t WS_SBOUT = 158 * MiB;
constexpr size_t WS_DFIN = 160 * MiB;
constexpr size_t WS_DFOUT = 166 * MiB;
constexpr size_t WS_HH = 168 * MiB;
constexpr size_t WS_H = 200 * MiB;
constexpr size_t WS_Y = 288 * MiB;
constexpr size_t WS_VT = 288 * MiB;
constexpr size_t WS_XB = 352 * MiB;
constexpr size_t WS_O = 384 * MiB;
constexpr size_t WS_KCMP = 416 * MiB;
constexpr size_t WS_VCMPT = 417 * MiB;
constexpr size_t WS_MODP = 420 * MiB;
constexpr size_t WS_CMPBP = 424 * MiB;
constexpr size_t WS_BAR = 768 * 1024;
constexpr size_t WS_XSLOT = 425 * MiB;
constexpr size_t WS_PCNT = 800 * 1024;
constexpr size_t WS_KMAX = 820 * 1024;
constexpr size_t WS_CTR = 824 * 1024;
constexpr size_t WS_END = 426 * MiB;

constexpr int LDS_BYTES = 147456;

#define LAS __attribute__((address_space(3)))
typedef unsigned short bf16;
typedef short bf16x8 __attribute__((ext_vector_type(8)));
typedef float f32x4 __attribute__((ext_vector_type(4)));
typedef float f32x16 __attribute__((ext_vector_type(16)));
typedef unsigned u32x4 __attribute__((ext_vector_type(4)));
typedef unsigned u32x2 __attribute__((ext_vector_type(2)));
typedef LAS unsigned char lds_u8;

__device__ __forceinline__ unsigned pk2(float lo, float hi) { return pg8::cvt_pk_bf16(lo, hi); }
__device__ __forceinline__ float bf2f(unsigned short v) { return __uint_as_float((unsigned)v << 16); }
__device__ __forceinline__ float ex2(float x) { return __builtin_amdgcn_exp2f(x); }
__device__ __forceinline__ float lg2(float x) { return __builtin_amdgcn_logf(x); }
__device__ __forceinline__ float wave_sum(float v) {
#pragma unroll
    for (int o = 1; o < 64; o <<= 1) v += __shfl_xor(v, o);
    return v;
}
__device__ __forceinline__ int crow(int r, int hi) { return (r & 3) + 8 * (r >> 2) + 4 * hi; }

template <class Tp> __device__ __forceinline__ Tp* uni_ptr(Tp* p) { const unsigned long long v = (unsigned long long)p;
    const unsigned lo = __builtin_amdgcn_readfirstlane((unsigned)v), hi = __builtin_amdgcn_readfirstlane((unsigned)(v >> 32)); return (Tp*)(((unsigned long long)hi << 32) | lo); }
__device__ __forceinline__ float uni_f(float x) { return __uint_as_float(__builtin_amdgcn_readfirstlane(__float_as_uint(x))); }
__device__ __forceinline__ unsigned uni_u(unsigned x) { return __builtin_amdgcn_readfirstlane(x); }

struct Args { const float* in[18]; float* out; unsigned char* ws; int ph_lo, ph_hi; };

__device__ __forceinline__ void transpose_item(const float* W, int ldw, int nvalid, int K, bf16* WT, int k0, int n0, int drow0, LAS float* scr, int lane) {
    const int r8 = lane >> 3, c4 = lane & 7;
#pragma unroll
    for (int i = 0; i < 8; ++i) { const int kk = 8 * i + r8; const int n = n0 + 4 * c4;
        f32x4 v = {0.f, 0.f, 0.f, 0.f};
        if (n < nvalid) v = *(const f32x4*)(W + (size_t)(k0 + kk) * ldw + n);
        LAS float* d = scr + kk * 33 + 4 * c4; d[0] = v.x; d[1] = v.y; d[2] = v.z; d[3] = v.w; }
    asm volatile("s_waitcnt lgkmcnt(0)" ::: "memory");
    const int c = lane & 7;
#pragma unroll
    for (int j = 0; j < 4; ++j) { const int n = (lane >> 3) + 8 * j; const LAS float* s = scr + (8 * c) * 33 + n;
        u32x4 o; o.x = pk2(s[0 * 33], s[1 * 33]); o.y = pk2(s[2 * 33], s[3 * 33]); o.z = pk2(s[4 * 33], s[5 * 33]); o.w = pk2(s[6 * 33], s[7 * 33]);
        *(u32x4*)(WT + (size_t)(drow0 + n) * K + k0 + 8 * c) = o; }
    asm volatile("s_waitcnt lgkmcnt(0)" ::: "memory");
}
__device__ __forceinline__ void transpose_plain(const float* W, int K, int N, int Npad, bf16* WT, int item, LAS float* scr, int lane) {
    const int nblk = Npad / 32, kb = item / nblk, nb = item % nblk;
    transpose_item(W, N, N, K, WT, 64 * kb, 32 * nb, 32 * nb, scr, lane);
}
__device__ __forceinline__ float siluf(float x) { return x * __builtin_amdgcn_rcpf(1.0f + __expf(-x)); }

template <int NB>
__device__ __forceinline__ void gemv_item(const float* W, int ldw, int kbeg, int klen, int n0, const float* svec, int sstride, bool do_silu, const float* bias, float* out, int ostride, int lane) {
    f32x4 a0 = {0.f, 0.f, 0.f, 0.f}, a1 = {0.f, 0.f, 0.f, 0.f};
    const float* wp = W + (size_t)kbeg * ldw + n0 + 4 * lane;
#pragma unroll 16
    for (int k = 0; k < klen; ++k) {
        const f32x4 w = *(const f32x4*)(wp + (size_t)k * ldw);
        float s0 = svec[kbeg + k]; if (do_silu) s0 = siluf(s0);
        a0 += w * s0;
        if (NB == 2) { float s1 = svec[sstride + kbeg + k]; if (do_silu) s1 = siluf(s1); a1 += w * s1; }
    }
    (void)bias;
    float* o = out + n0 + 4 * lane;
    *(f32x4*)o = a0; if (NB == 2) *(f32x4*)(o + ostride) = a1;
}

__device__ __forceinline__ void p0_prologue(const Args& A, LAS unsigned char* lds, int gw, int NGW, int wave, int lane, int lsel, int half) {
    LAS float* scr = (LAS float*)(lds + wave * 16384);
    unsigned char* ws = A.ws;
    constexpr int I_W1 = (D / 64) * (2 * DFF / 32);
    constexpr int I_W2 = (DFF / 64) * (D / 32);
    constexpr int I_NIN = (D / 64) * (NSA_PITCH / 32);
    constexpr int I_SQ = (D / 64) * (D / 32);
    constexpr int I_CW1 = (2048 / 64) * (256 / 32);
    constexpr int I_IN3 = (D / 64) * (3 * D / 32);
    constexpr int I_ADA = DEPTH * 36 * 8;
    constexpr int I_PEB = 4 * 16;
    constexpr int NITEMS = 8 * I_W1 + 8 * I_W2 + 2 * I_NIN + 2 * I_SQ + 4 * I_CW1 + 2 * I_IN3 + 2 * I_SQ + I_ADA + I_PEB;
    int kcount = 0;
#define P0_TAKE(LAY) { if (lsel >= 0 && (LAY) != lsel) continue; const int kc_ = kcount++; if (half >= 0 && (kc_ & 1) != half) continue; }
    for (int it = gw; it < NITEMS; it += NGW) {
        int r = it;
        if (r < I_ADA) {
            P0_TAKE(0)
            const int l = r / 288, rr = r % 288, cgp = rr / 8, kc = rr % 8;
            gemv_item<2>(A.in[2] + (size_t)l * D * 9216, 9216, kc * 128, 128, cgp * 256, A.in[1], D, true, nullptr,
                         (float*)(ws + WS_MODP) + ((size_t)kc * 4 + l) * 2 * 9216, 9216, lane);
            continue; }
        r -= I_ADA;
        if (r < I_PEB) {
            P0_TAKE(0)
            const int jk = r / 16, kc = r % 16;
            gemv_item<1>(A.in[9] + (size_t)jk * 2048 * 256, 256, kc * 128, 128, 0, A.in[8] + (size_t)jk * 2048, 0, false, nullptr, (float*)(ws + WS_CMPBP) + ((size_t)kc * 4 + jk) * 256, 0, lane);
            continue; }
        r -= I_PEB;
        if (r < 8 * I_W1) {
            const int sub = r / I_W1, rr = r % I_W1, nblk = 2 * DFF / 32, kb = rr / nblk, nb = rr % nblk, n0 = 32 * nb;
            P0_TAKE(sub >> 1)
            const int n1 = n0 < DFF ? n0 : n0 - DFF; const int drow = (n1 / 128) * 256 + (n0 < DFF ? 0 : 128) + (n1 % 128);
            transpose_item(A.in[5] + (size_t)sub * D * 2 * DFF, 2 * DFF, 2 * DFF, D, (bf16*)(ws + WS_W1T) + (size_t)sub * 2 * DFF * D, 64 * kb, n0, drow, scr, lane);
            continue; }
        r -= 8 * I_W1;
        if (r < 8 * I_W2) { const int sub = r / I_W2; P0_TAKE(sub >> 1) transpose_plain(A.in[6] + (size_t)sub * DFF * D, DFF, D, D, (bf16*)(ws + WS_W2T) + (size_t)sub * D * DFF, r % I_W2, scr, lane); continue; }
        r -= 8 * I_W2;
        if (r < 2 * I_NIN) { const int sub = r / I_NIN; P0_TAKE(sub * 3) transpose_plain(A.in[7] + (size_t)sub * D * 2608, D, 2608, NSA_PITCH, (bf16*)(ws + WS_NSAIN) + (size_t)sub * NSA_PITCH * D, r % I_NIN, scr, lane); continue; }
        r -= 2 * I_NIN;
        if (r < 2 * I_SQ) { const int sub = r / I_SQ; P0_TAKE(sub * 3) transpose_plain(A.in[11] + (size_t)sub * D * D, D, D, D, (bf16*)(ws + WS_NSAOUT) + (size_t)sub * D * D, r % I_SQ, scr, lane); continue; }
        r -= 2 * I_SQ;
        if (r < 4 * I_CW1) { const int sub = r / I_CW1; P0_TAKE((sub >> 1) * 3) transpose_plain(A.in[9] + (size_t)sub * 2048 * 256, 2048, 256, 256, (bf16*)(ws + WS_CMPW1) + (size_t)sub * 256 * 2048, r % I_CW1, scr, lane); continue; }
        r -= 4 * I_CW1;
        if (r < I_IN3) { P0_TAKE(1) transpose_plain(A.in[12], D, 3 * D, 3 * D, (bf16*)(ws + WS_SBIN), r, scr, lane); continue; }
        r -= I_IN3;
        if (r < I_IN3) { P0_TAKE(2) transpose_plain(A.in[14], D, 3 * D, 3 * D, (bf16*)(ws + WS_DFIN), r, scr, lane); continue; }
        r -= I_IN3;
        if (r < I_SQ) { P0_TAKE(1) transpose_plain(A.in[13], D, D, D, (bf16*)(ws + WS_SBOUT), r, scr, lane); continue; }
        r -= I_SQ;
        P0_TAKE(2)
        transpose_plain(A.in[17], D, D, D, (bf16*)(ws + WS_DFOUT), r, scr, lane);
    }
#undef P0_TAKE
}

__device__ __forceinline__ void p0_reduce(const Args& A, int G, int bid, int tid) {
    unsigned char* ws = A.ws;
    const float* modp = (const float*)(ws + WS_MODP); float* mod = (float*)(ws + WS_MOD);
    const float* cp = (const float*)(ws + WS_CMPBP); float* cb = (float*)(ws + WS_CMPB);
    constexpr int NMOD = 4 * 2 * 9216;
    for (int i = bid * 512 + tid; i < NMOD + 1024; i += G * 512) {
        if (i < NMOD) { const int l = i / (2 * 9216), n = i % 9216; float s = A.in[3][l * 9216 + n];
#pragma unroll
            for (int kc = 0; kc < 8; ++kc) s += modp[(size_t)kc * NMOD + i];
            mod[i] = s; }
        else { const int j = i - NMOD; float s = 0.f;
#pragma unroll
            for (int kc = 0; kc < 16; ++kc) s += cp[kc * 1024 + j];
            cb[j] = s; }
    }
}

__device__ __forceinline__ void row_phase(const float* Xin, const float* Y, float* Xout, bf16* XBout, bf16* HH,
                                          const float* mod_post  , int sidx_post, const float* g_post, float res_w,
                                          const float* mod_pre, int sidx_pre, const float* g_pre, int G, int bid, int wave, int lane) {
    const int gw = bid * NWAVES + wave, NGW = G * NWAVES;
#define RIDX(j) (2 * lane + 128 * ((j) >> 1) + ((j) & 1))
    for (int m = gw; m < M; m += NGW) {
        const int b = m / T;
        const f32x4* xr = (const f32x4*)(Xin + (size_t)m * D);
        f32x4 x[4];
#pragma unroll
        for (int j = 0; j < 4; ++j) x[j] = xr[RIDX(j)];
        if (Y) {
            const f32x4* yr = (const f32x4*)(Y + (size_t)m * D);
            f32x4 y[4]; float s = 0.f;
#pragma unroll
            for (int j = 0; j < 4; ++j) { y[j] = yr[RIDX(j)]; s += (y[j].x * y[j].x + y[j].y * y[j].y) + (y[j].z * y[j].z + y[j].w * y[j].w); }
            const float rstd = rsqrtf(wave_sum(s) * (1.f / D) + EPS) * res_w;
            const float* gate = mod_post + (size_t)b * 9216 + (sidx_post * 3 + 2) * D;
#pragma unroll
            for (int j = 0; j < 4; ++j) { const f32x4 gt = *((const f32x4*)gate + RIDX(j)), gp = *((const f32x4*)g_post + RIDX(j));
                x[j] += gt * gp * (y[j] * rstd); }
        }
        if (XBout) { u32x4* xb = (u32x4*)(XBout + (size_t)m * D) + lane;
#pragma unroll
            for (int q = 0; q < 2; ++q) { u32x4 w; w.x = pg8::cvt_pk_f16(x[2 * q].x, x[2 * q].y); w.y = pg8::cvt_pk_f16(x[2 * q].z, x[2 * q].w);
                w.z = pg8::cvt_pk_f16(x[2 * q + 1].x, x[2 * q + 1].y); w.w = pg8::cvt_pk_f16(x[2 * q + 1].z, x[2 * q + 1].w); xb[64 * q] = w; } }
        if (Xout) { f32x4* xo = (f32x4*)(Xout + (size_t)m * D);
#pragma unroll
            for (int j = 0; j < 4; ++j) xo[RIDX(j)] = x[j]; }
        if (HH) {
            float s = 0.f;
#pragma unroll
            for (int j = 0; j < 4; ++j) s += (x[j].x * x[j].x + x[j].y * x[j].y) + (x[j].z * x[j].z + x[j].w * x[j].w);
            const float rstd = rsqrtf(wave_sum(s) * (1.f / D) + EPS);
            const float* shift = mod_pre + (size_t)b * 9216 + (sidx_pre * 3 + 0) * D; const float* scl = shift + D;
            u32x4* ho = (u32x4*)(HH + (size_t)m * D) + lane;
#pragma unroll
            for (int q = 0; q < 2; ++q) { u32x4 w;
#pragma unroll
                for (int e = 0; e < 2; ++e) { const int j = 2 * q + e;
                    const f32x4 sh = *((const f32x4*)shift + RIDX(j)), sc = *((const f32x4*)scl + RIDX(j)), gp = *((const f32x4*)g_pre + RIDX(j));
                    const f32x4 h = x[j] * rstd * gp * (sc + 1.0f) + sh;
                    if (e == 0) { w.x = pk2(h.x, h.y); w.y = pk2(h.z, h.w); } else { w.z = pk2(h.x, h.y); w.w = pk2(h.z, h.w); } }
                ho[64 * q] = w; }
        }
    }
#undef RIDX
}

constexpr int KP64 = 144;
constexpr int KP128 = 272;
constexpr int TILE64 = 64 * KP64;

__device__ __forceinline__ f32x16 zero16() { f32x16 z; for (int i = 0; i < 16; ++i) z[i] = 0.f; return z; }
#define MFMA32(a, b, c) __builtin_amdgcn_mfma_f32_32x32x16_bf16((a), (b), (c), 0, 0, 0)

__device__ __forceinline__ void qk_tile(f32x16& s0, f32x16& s1, const lds_u8* Kt, int pitch, const bf16x8 (&qf)[4], int r32, int hi) {
    const lds_u8* p = Kt + r32 * pitch + hi * 16;
    s0 = zero16(); s1 = zero16();
#pragma unroll
    for (int ks = 0; ks < 4; ++ks) {
        const bf16x8 a0 = *(const LAS bf16x8*)(p + ks * 32);
        const bf16x8 a1 = *(const LAS bf16x8*)(p + 32 * pitch + ks * 32);
        s0 = MFMA32(a0, qf[ks], s0); s1 = MFMA32(a1, qf[ks], s1);
    }
}
template <int NDB>
__device__ __forceinline__ void pv_tile(f32x16 (&o)[NDB], const lds_u8* Vt, const bf16x8 (&pf)[4], int r32, int hi) {
    const lds_u8* p = Vt + r32 * KP64 + hi * 16;
#pragma unroll
    for (int j = 0; j < 4; ++j) {
        bf16x8 a[NDB];
#pragma unroll
        for (int db = 0; db < NDB; ++db) a[db] = *(const LAS bf16x8*)(p + db * 32 * KP64 + j * 32);
#pragma unroll
        for (int db = 0; db < NDB; ++db) o[db] = MFMA32(a[db], pf[j], o[db]);
    }
}
__device__ __forceinline__ void pack_p(bf16x8 (&pf)[4], const f32x16& p0, const f32x16& p1) {
#pragma unroll
    for (int j = 0; j < 4; ++j) {
        const f32x16& s = (j < 2) ? p0 : p1; const int o = 8 * (j & 1);
        u32x4 w; w.x = pk2(s[o + 0], s[o + 1]); w.y = pk2(s[o + 2], s[o + 3]); w.z = pk2(s[o + 4], s[o + 5]); w.w = pk2(s[o + 6], s[o + 7]);
        pf[j] = __builtin_bit_cast(bf16x8, w);
    }
}
template <int NDB>
__device__ __forceinline__ void softmax_step(f32x16& s0, f32x16& s1, float& m, float& l, f32x16 (&o)[NDB]) {
    float mx = s0[0];
#pragma unroll
    for (int r = 1; r < 16; ++r) mx = fmaxf(mx, s0[r]);
#pragma unroll
    for (int r = 0; r < 16; ++r) mx = fmaxf(mx, s1[r]);
    mx = fmaxf(mx, __shfl_xor(mx, 32));
    const float mn = fmaxf(m, mx), alpha = ex2(m - mn);
    m = mn;
    float sum = 0.f;
#pragma unroll
    for (int r = 0; r < 16; ++r) { s0[r] = ex2(s0[r] - mn); s1[r] = ex2(s1[r] - mn); sum += s0[r] + s1[r]; }
    l = l * alpha + sum;
#pragma unroll
    for (int db = 0; db < NDB; ++db) o[db] *= alpha;
}
__device__ __forceinline__ void st_k64(lds_u8* Kb, u32x4 v, int tid) { *(LAS u32x4*)(Kb + (tid >> 3) * KP64 + (tid & 7) * 16) = v; }
__device__ __forceinline__ void st_vt64(lds_u8* Vb, u32x4 v, int row, int c) {
    lds_u8* p = Vb + row * KP64 + 32 * (c >> 1) + 8 * (c & 1);
    *(LAS u32x2*)p = (u32x2){v.x, v.y}; *(LAS u32x2*)(p + 16) = (u32x2){v.z, v.w};
}

constexpr int KPA64 = 176, KPA128 = 304;
constexpr int TILEA64 = 64 * KPA64;
__device__ __forceinline__ bf16x8 alibi_qfrag(float slope2, int hi) {
    const unsigned h0 = pk2(slope2, 0.f) & 0xffffu; const float f0 = __uint_as_float(h0 << 16);
    const float r1 = slope2 - f0; const unsigned h1 = pk2(r1, 0.f) & 0xffffu; const float f1 = __uint_as_float(h1 << 16);
    const float r2 = r1 - f1; const unsigned h2 = pk2(r2, 0.f) & 0xffffu;
    const unsigned g0 = pk2(64.f * f0, 0.f) & 0xffffu, g1 = pk2(64.f * f1, 0.f) & 0xffffu, g2 = pk2(64.f * __uint_as_float(h2 << 16), 0.f) & 0xffffu;
    u32x4 w; w.x = g0 | (g1 << 16); w.y = g2 | (h0 << 16); w.z = h1 | (h2 << 16); w.w = 0u;
    if (hi) w = (u32x4){0u, 0u, 0u, 0u};
    return __builtin_bit_cast(bf16x8, w);
}
__device__ __forceinline__ void st_kextra(lds_u8* rowp, int pos) {
    const unsigned a = pk2((float)(pos >> 6), 0.f) & 0xffffu, b = pk2((float)(pos & 63), 0.f) & 0xffffu;
    u32x4 w; w.x = a | (a << 16); w.y = a | (b << 16); w.z = b | (b << 16); w.w = 0u;
    *(LAS u32x4*)rowp = w; *(LAS u32x4*)(rowp + 16) = (u32x4){0u, 0u, 0u, 0u};
}
__device__ __forceinline__ void qk_tile5(f32x16& s0, f32x16& s1, const lds_u8* Kt, int pitch, int colB, int extraB, const bf16x8 (&qf)[4], bf16x8 qx, const f32x16& cinit, int r32, int hi) {
    const lds_u8* p = Kt + r32 * pitch + hi * 16;
    {
        const bf16x8 a0 = *(const LAS bf16x8*)(p + colB), a1 = *(const LAS bf16x8*)(p + 32 * pitch + colB);
        s0 = MFMA32(a0, qf[0], cinit); s1 = MFMA32(a1, qf[0], cinit);
    }
#pragma unroll
    for (int ks = 1; ks < 4; ++ks) {
        const bf16x8 a0 = *(const LAS bf16x8*)(p + colB + ks * 32), a1 = *(const LAS bf16x8*)(p + 32 * pitch + colB + ks * 32);
        s0 = MFMA32(a0, qf[ks], s0); s1 = MFMA32(a1, qf[ks], s1);
    }
    {
        const bf16x8 a0 = *(const LAS bf16x8*)(p + extraB), a1 = *(const LAS bf16x8*)(p + 32 * pitch + extraB);
        s0 = MFMA32(a0, qx, s0); s1 = MFMA32(a1, qx, s1);
    }
}
__device__ __forceinline__ f32x16 splat16(float v) { f32x16 z; for (int i = 0; i < 16; ++i) z[i] = v; return z; }
template <int NDB>
__device__ __forceinline__ void softmax_rel(f32x16& s0, f32x16& s1, float& m, f32x16& negm, float& l, f32x16 (&o)[NDB]) {
    float mx = fmaxf(s0[0], s1[0]);
#pragma unroll
    for (int r = 1; r < 16; ++r) mx = fmaxf(fmaxf(mx, s0[r]), s1[r]);
    mx = fmaxf(mx, __shfl_xor(mx, 32));
    if (__any(mx > 0.f)) {
        const float delta = fmaxf(mx, 0.f), alpha = ex2(-delta);
        m += delta; l *= alpha; negm = splat16(-m);
#pragma unroll
        for (int db = 0; db < NDB; ++db) o[db] *= alpha;
#pragma unroll
        for (int r = 0; r < 16; ++r) { s0[r] -= delta; s1[r] -= delta; }
    }
    float sum = 0.f;
#pragma unroll
    for (int r = 0; r < 16; ++r) { s0[r] = ex2(s0[r]); s1[r] = ex2(s1[r]); sum += s0[r] + s1[r]; }
    l += sum;
}

typedef short v4i16_t __attribute__((ext_vector_type(4)));
__device__ __forceinline__ void st_vpiece(lds_u8* Vb, u32x4 v, int krow, int c) {
    *(LAS u32x4*)(Vb + ((c >> 2) * 4 + (krow >> 4)) * 1024 + (krow & 15) * 64 + (c & 3) * 16) = v;
}
template <int NDB>
__device__ __forceinline__ void pv_tile_tr(f32x16 (&o)[NDB], const lds_u8* Vb, const bf16x8 (&pf)[4], int lane, int hi) {
    const lds_u8* vb = Vb + ((lane >> 4) & 1) * 32 + (lane & 3) * 8 + (4 * hi + ((lane & 15) >> 2)) * 64;
#pragma unroll
    for (int j = 0; j < 4; ++j) {
        bf16x8 a[NDB];
#pragma unroll
        for (int db = 0; db < NDB; ++db) {
            const v4i16_t lo = __builtin_amdgcn_ds_read_tr16_b64_v4i16((LAS v4i16_t*)(vb + db * 4096 + j * 1024));
            const v4i16_t h4 = __builtin_amdgcn_ds_read_tr16_b64_v4i16((LAS v4i16_t*)(vb + db * 4096 + j * 1024 + 512));
            a[db] = (bf16x8){lo[0], lo[1], lo[2], lo[3], h4[0], h4[1], h4[2], h4[3]};
        }
#pragma unroll
        for (int db = 0; db < NDB; ++db) o[db] = MFMA32(a[db], pf[j], o[db]);
    }
}

template <int NDB>
__device__ __forceinline__ void vtr_issue(v4i16_t (&vf)[8 * NDB], const lds_u8* Vb, int lane, int hi) {
    const unsigned vb = (unsigned)(size_t)(Vb + ((lane >> 4) & 1) * 32 + (lane & 3) * 8 + (4 * hi + ((lane & 15) >> 2)) * 64);
#pragma unroll
    for (int db = 0; db < NDB; ++db)
#pragma unroll
        for (int j = 0; j < 4; ++j) {
            asm volatile("ds_read_b64_tr_b16 %0, %1 offset:%c2" : "=&v"(vf[(db * 4 + j) * 2]) : "v"(vb), "i"(db * 4096 + j * 1024) : "memory");
            asm volatile("ds_read_b64_tr_b16 %0, %1 offset:%c2" : "=&v"(vf[(db * 4 + j) * 2 + 1]) : "v"(vb), "i"(db * 4096 + j * 1024 + 512) : "memory");
        }
}
template <int NDB>
__device__ __forceinline__ void vtr_mfma(f32x16 (&o)[NDB], const v4i16_t (&vf)[8 * NDB], const bf16x8 (&pf)[4]) {
#pragma unroll
    for (int j = 0; j < 4; ++j)
#pragma unroll
        for (int db = 0; db < NDB; ++db) {
            const v4i16_t lo = vf[(db * 4 + j) * 2], h4 = vf[(db * 4 + j) * 2 + 1];
            const bf16x8 a = (bf16x8){lo[0], lo[1], lo[2], lo[3], h4[0], h4[1], h4[2], h4[3]};
            o[db] = MFMA32(a, pf[j], o[db]);
        }
}
#define LGKM_WAIT_SB() do { asm volatile("s_waitcnt lgkmcnt(0)" ::: "memory"); __builtin_amdgcn_sched_barrier(0); } while (0)

__device__ __forceinline__ float gelu_tanh(float x) {
    const float u = 0.7978845608028654f * (x + 0.044715f * x * x * x);
    const float e = __expf(-2.0f * fabsf(u)); const float th = (1.0f - e) / (1.0f + e);
    return 0.5f * x * (1.0f + (u < 0.f ? -th : th));
}
__device__ __forceinline__ void compress_phase(const bf16* P, const bf16* W1T  , const float* cmpb  , const float* W2  ,
                                               bf16* kcmp, bf16* vcmpT, lds_u8* lds, int G, int bid, int tid) {
    const int wave = tid >> 6, lane = tid & 63, r32 = lane & 31, hi = lane >> 5;
    constexpr int CA = 0, CB = 528 * 128, CBSZ = 256 * 128;
    LAS float* hid = (LAS float*)(lds + CB);
    LAS f32x4* w2l = (LAS f32x4*)(lds + CA);
    for (int u = bid; u < 256; u += G) {
        const int nb = u & 15, g = (u >> 4) & 3, b = (u >> 6) & 1, kv = u >> 7;
        f32x4 w2r[8];
#pragma unroll
        for (int i = 0; i < 8; ++i) w2r[i] = *((const f32x4*)(W2 + (size_t)kv * 256 * 64) + tid + 512 * i);
        const bf16* abase = P + (size_t)b * T * NSA_PITCH + 1024 + kv * 256 + g * 64;
#pragma unroll
        for (int k = 0; k < 9; ++k) { const int id = tid + 512 * k;
            if (id < 528 * 8) { const int t = id >> 3, c = id & 7; int gt = 512 * nb + t; gt = gt < T ? gt : T - 1;
                const u32x4 v = *(const u32x4*)(abase + (size_t)gt * NSA_PITCH + c * 8);
                *(LAS u32x4*)(lds + CA + t * 128 + ((c ^ ((t >> 4) & 7)) * 16)) = v; } }
        const bf16* bbase = W1T + (size_t)kv * 256 * 2048;
        u32x4 brA[4], brB[4];
#define CMP_LOADB(BR, L) do { _Pragma("unroll") for (int k = 0; k < 4; ++k) { const int id = tid + 512 * k; BR[k] = *(const u32x4*)(bbase + (size_t)(id >> 3) * 2048 + (L) * 64 + (id & 7) * 8); } } while (0)
        CMP_LOADB(brA, 0); CMP_LOADB(brB, 1);
        f32x16 acc = zero16();
        const int acol = wave * 32 + r32;
        for (int l0 = 0; l0 < 32; l0 += 2) {
#pragma unroll
            for (int hh = 0; hh < 2; ++hh) { const int l = l0 + hh;
                u32x4 (&br)[4] = hh ? brB : brA;
                lds_u8* Bb = lds + CB + hh * CBSZ;
#pragma unroll
                for (int k = 0; k < 4; ++k) { const int id = tid + 512 * k; const int col = id >> 3, c = id & 7;
                    *(LAS u32x4*)(Bb + col * 128 + ((c ^ ((col >> 1) & 7)) * 16)) = br[k]; }
                __syncthreads();
                if (l + 2 < 32) CMP_LOADB(br, l + 2);
                const int arow = 16 * r32 + l;
                const lds_u8* ap = lds + CA + arow * 128; const int akey = (arow >> 4) & 7;
                const lds_u8* bp = Bb + acol * 128; const int bkey = (acol >> 1) & 7;
#pragma unroll
                for (int ks = 0; ks < 4; ++ks) {
                    const bf16x8 a = *(const LAS bf16x8*)(ap + (((2 * ks + hi) ^ akey) * 16)), bb = *(const LAS bf16x8*)(bp + (((2 * ks + hi) ^ bkey) * 16));
                    acc = MFMA32(a, bb, acc);
                }
            }
        }
        __syncthreads();
        const float bias = cmpb[kv * 256 + wave * 32 + r32];
#pragma unroll
        for (int r = 0; r < 16; ++r) hid[crow(r, hi) * 260 + wave * 32 + r32] = gelu_tanh(acc[r] + bias);
#pragma unroll
        for (int i = 0; i < 8; ++i) w2l[tid + 512 * i] = w2r[i];
        __syncthreads();
        {
            const int row = tid >> 4, d4 = tid & 15;
            f32x4 o = {0.f, 0.f, 0.f, 0.f};
#pragma unroll 8
            for (int j = 0; j < 256; ++j) o += w2l[j * 16 + d4] * hid[row * 260 + j];
            const int nn = nb * 32 + row;
            if (nn >= 511) o = (f32x4){0.f, 0.f, 0.f, 0.f};
            if (kv == 0) { u32x2 w; w.x = pk2(o.x, o.y); w.y = pk2(o.z, o.w); *(u32x2*)(kcmp + ((size_t)b * 512 + nn) * 256 + g * 64 + d4 * 4) = w; }
            else {
#pragma unroll
                for (int j = 0; j < 4; ++j) vcmpT[((size_t)b * 256 + g * 64 + d4 * 4 + j) * 512 + nn] = (bf16)(pk2(o[j], 0.f) & 0xffffu);
            }
        }
        __syncthreads();
    }
}
#define RLX_AGENT __ATOMIC_RELAXED, __HIP_MEMORY_SCOPE_AGENT
#define XB_TMO      128
#define XB_XCNT(j)  (256  + 64 * (j))
#define XB_XSUB(j)  (1280 + 64 * (j))
#define XB_XGEN(j)  (2304 + 64 * (j))
#define XB_TOP      3328
#define XB_TOPGEN   3392
#define XCD_BAR_WORDS 3456
#define XB_SPIN_CAP (1u << 18)

__device__ __forceinline__ unsigned xb_ld(unsigned* p)              { return __hip_atomic_load(p, __ATOMIC_RELAXED, __HIP_MEMORY_SCOPE_AGENT); }
__device__ __forceinline__ unsigned xb_add(unsigned* p, unsigned v) { return __hip_atomic_fetch_add(p, v, __ATOMIC_RELAXED, __HIP_MEMORY_SCOPE_AGENT); }
__device__ __forceinline__ unsigned xb_xcc_id() { return (unsigned)__builtin_amdgcn_s_getreg((3 << 11) | 20) & 0xFu; }
#define XB_SPIN(cond, bar) do { unsigned _sp = 0; while (cond) { __builtin_amdgcn_s_sleep(1); \
    if ((++_sp & 255u) == 0u) { if (xb_ld(&(bar)[XB_TMO])) break; if (_sp > XB_SPIN_CAP) { atomicAdd(&(bar)[XB_TMO], 1u); break; } } } } while (0)

struct XcdBarrier {
    unsigned* bar; unsigned x;
    volatile LAS unsigned* st;
};

__device__ __forceinline__ XcdBarrier xcd_barrier_post(unsigned* bar, volatile LAS unsigned* st) {
    XcdBarrier b; b.bar = bar; b.x = xb_xcc_id(); b.st = st;
    if (threadIdx.x == 0) (void)xb_add(&bar[XB_XCNT(b.x)], 1u);
    return b;
}
__device__ __forceinline__ void xcd_barrier_complete(unsigned* bar, unsigned x, unsigned& nloc, unsigned& nx) {
    const unsigned G = gridDim.x * gridDim.y * gridDim.z;
    unsigned sum, cnt, mine, sp = 0u;
    for (;;) {
        sum = 0u; cnt = 0u; mine = 0u;
#pragma unroll
        for (unsigned j = 0; j < 16; ++j) { const unsigned c = xb_ld(&bar[XB_XCNT(j)]); sum += c; cnt += (c > 0u) ? 1u : 0u; mine = (j == x) ? c : mine; }
        if (sum == G) break;
        __builtin_amdgcn_s_sleep(1);
        if ((++sp & 255u) == 0u) { if (xb_ld(&bar[XB_TMO])) break; if (sp > XB_SPIN_CAP) { atomicAdd(&bar[XB_TMO], 1u); break; } }
    }
    nloc = mine > 0u ? mine : 1u; nx = cnt > 0u ? cnt : 1u;
}

__device__ __forceinline__ void xcd_barrier(const XcdBarrier& b) {
    asm volatile("s_waitcnt vmcnt(0)" ::: "memory");
    __syncthreads();
    if (threadIdx.x == 0) {
        unsigned* bar = b.bar;
        __builtin_amdgcn_s_waitcnt(0);
        unsigned nloc = b.st[0], nx = b.st[1];
        if (nloc == 0u) { xcd_barrier_complete(bar, b.x, nloc, nx); b.st[0] = nloc; b.st[1] = nx; }
        const unsigned old = xb_add(&bar[XB_XSUB(b.x)], 1u);
        const unsigned gen = old / nloc;
        if (old + 1u == (gen + 1u) * nloc) {
            __builtin_amdgcn_fence(__ATOMIC_RELEASE, "agent");
            asm volatile("s_waitcnt vmcnt(0)" ::: "memory");
            const unsigned og = xb_add(&bar[XB_TOP], 1u);
            const unsigned tg = og / nx;
            if (og + 1u == (tg + 1u) * nx) xb_add(&bar[XB_TOPGEN], 1u);
            else XB_SPIN(xb_ld(&bar[XB_TOPGEN]) == tg, bar);
            __builtin_amdgcn_fence(__ATOMIC_ACQUIRE, "agent");
            xb_add(&bar[XB_XGEN(b.x)], 1u);
            asm volatile("s_waitcnt vmcnt(0)" ::: "memory");
        } else {
            XB_SPIN(xb_ld(&bar[XB_XGEN(b.x)]) == gen, bar);
            __builtin_amdgcn_fence(__ATOMIC_ACQUIRE, "agent");
            asm volatile("s_waitcnt vmcnt(0)" ::: "memory");
        }
    }
    __syncthreads();
}
#define TL_BEGIN(LOADV, NT, KPTR, VPTR) { \
    const int _nt = (NT); u32x4 _krA = {0u, 0u, 0u, 0u}, _vrA = {0u, 0u, 0u, 0u}, _krB = {0u, 0u, 0u, 0u}, _vrB = {0u, 0u, 0u, 0u}; \
    if (_nt > 0) { const int ti = 0; (void)ti; _krA = *(const u32x4*)(KPTR); if (LOADV) _vrA = *(const u32x4*)(VPTR); } \
    if (_nt > 1) { const int ti = 1; (void)ti; _krB = *(const u32x4*)(KPTR); if (LOADV) _vrB = *(const u32x4*)(VPTR); } \
    for (int _i = 0; _i < _nt; _i += 2) { \
      _Pragma("unroll") for (int _h = 0; _h < 2; ++_h) { const int _t = _i + _h; if (_t < _nt) { \
        u32x4& _kc = _h ? _krB : _krA; u32x4& _vc = _h ? _vrB : _vrA; \
        lds_u8* Kb = lds + _h * TILE64; lds_u8* Vb = lds + 2 * TILE64 + _h * TILE64; (void)Vb; \
        st_k64(Kb, _kc, tid); if ((LOADV) == 1) st_vt64(Vb, _vc, lrow, lc); else if ((LOADV) == 2) st_vpiece(Vb, _vc, lrow, lc); \
        __syncthreads(); \
          \
        if (_t + 2 < _nt) { const int ti = _t + 2; (void)ti; _kc = *(const u32x4*)(KPTR); if (LOADV) _vc = *(const u32x4*)(VPTR); } \
        { const int ti = _t; (void)ti;
#define TL_END } } } } __syncthreads(); }
template <int NDB>
__device__ __forceinline__ void store_ot(bf16* orow, const f32x16 (&o)[NDB], int hi) {
#pragma unroll
    for (int db = 0; db < NDB; ++db)
#pragma unroll
        for (int jp = 0; jp < 2; ++jp) {
            const int j0 = 2 * jp, j1 = 2 * jp + 1;
            u32x2 g0, g1;
            g0.x = pk2(o[db][4 * j0], o[db][4 * j0 + 1]); g0.y = pk2(o[db][4 * j0 + 2], o[db][4 * j0 + 3]);
            g1.x = pk2(o[db][4 * j1], o[db][4 * j1 + 1]); g1.y = pk2(o[db][4 * j1 + 2], o[db][4 * j1 + 3]);
            const unsigned sx = hi ? g0.x : g1.x, sy = hi ? g0.y : g1.y;
            const unsigned rx = __shfl_xor(sx, 32), ry = __shfl_xor(sy, 32);
            u32x4 w;
            if (hi) { w.x = rx; w.y = ry; w.z = g1.x; w.w = g1.y; } else { w.x = g0.x; w.y = g0.y; w.z = rx; w.w = ry; }
            *(u32x4*)(orow + 32 * db + 8 * (hi ? j1 : j0)) = w;
        }
}

#define CRF(r) ((float)(((r) & 3) + 8 * ((r) >> 2)))
template <int MODE>
__device__ __forceinline__ void bias_mask(f32x16& s0, f32x16& s1, float slope2, int dl, float& a0, float& a1) {
    a0 = NEGB; a1 = NEGB;
#pragma unroll
    for (int r = 0; r < 16; ++r) {
        const int d0 = dl + ((r & 3) + 8 * (r >> 2)), d1 = d0 + 32;
        float v0 = fmaf(slope2, CRF(r), s0[r]), v1 = fmaf(slope2, CRF(r), s1[r]);
        if (MODE == 1) { v0 = d0 <= 0 ? v0 : NEGB; v1 = d1 <= 0 ? v1 : NEGB; }
        if (MODE == 2) { v0 = d0 > -512 ? v0 : NEGB; v1 = d1 > -512 ? v1 : NEGB; }
        s0[r] = v0; s1[r] = v1; a0 = fmaxf(a0, v0); a1 = fmaxf(a1, v1);
    }
}
template <int NDB>
__device__ __forceinline__ void softmax_fast(f32x16& s0, f32x16& s1, float a0, float a1, float base, float c32, bool lane_on, float& m, float& l, f32x16 (&o)[NDB]) {
    float mx = lane_on ? fmaxf(a0, a1 + c32) + base : NEGB;
    mx = fmaxf(mx, __shfl_xor(mx, 32));
    if (__any(mx > m)) {
        const float mn = fmaxf(m, mx), alpha = ex2(m - mn); m = mn; l *= alpha;
#pragma unroll
        for (int db = 0; db < NDB; ++db) o[db] *= alpha;
    }
    const float sub0 = lane_on ? m - base : 1e30f, sub1 = sub0 - c32;
    float sum = 0.f;
#pragma unroll
    for (int r = 0; r < 16; ++r) { s0[r] = ex2(s0[r] - sub0); s1[r] = ex2(s1[r] - sub1); sum += s0[r] + s1[r]; }
    l += sum;
}

constexpr int NSA_LDS_IMP = 4 * TILE64, NSA_LDS_MASK = NSA_LDS_IMP + 64 * 129 * 4, NSA_LDS_LIST = NSA_LDS_MASK + 1024, NSA_LDS_SLOT = NSA_LDS_LIST + 520;
constexpr int NSA_LDS_TOT = 71680;
constexpr float IMP_FIX = 268435456.0f;

__device__ __forceinline__ void nsa_attn_phase(const bf16* P, const bf16* VT, const bf16* kcmp, const bf16* vcmpT, bf16* O, unsigned* ctr, lds_u8* lds, int G, int bid, int tid) {
    const int wave = tid >> 6, lane = tid & 63, r32 = lane & 31, hi = lane >> 5;
    const int lrow = tid >> 3, lc = tid & 7;
    LAS unsigned* imp = (LAS unsigned*)(lds + NSA_LDS_IMP);
    LAS unsigned* masks = (LAS unsigned*)(lds + NSA_LDS_MASK);
    LAS int* blist = (LAS int*)(lds + NSA_LDS_LIST);
    LAS int* slot = (LAS int*)(lds + NSA_LDS_SLOT);
    for (;;) {
        if (tid == 0) *slot = (int)atomicAdd(ctr, 1u);
        __syncthreads();
        const int ui = *slot;
        __syncthreads();
        if (ui >= 1024) break;
        const int qb = 127 - (ui >> 3);
        const int bg = ui & 7, b = bg >> 2, g = bg & 3;
        const int t0 = 64 * qb, h = 4 * g + (wave >> 1), qsub = wave & 1, ql = 32 * qsub + r32, tw0 = t0 + 32 * qsub, tq = t0 + ql;
        const size_t mq = (size_t)b * T + tq;
        const float slope2 = ex2(-0.5f * (float)(h + 1)) * LOG2E, c32 = slope2 * 32.0f;
        bf16x8 qf[4];
#pragma unroll
        for (int ks = 0; ks < 4; ++ks) qf[ks] = *(const bf16x8*)(P + mq * NSA_PITCH + h * 64 + 16 * ks + 8 * hi);
        for (int i = tid; i < 64 * 129; i += 512) imp[i] = 0u;
        const int ncmp = (4 * qb + 3) < 511 ? (4 * qb + 3) : 511, ntc = (ncmp + 63) >> 6;
        const bf16* kcb = kcmp + (size_t)b * 512 * 256 + g * 64;
        const bf16* vcb = vcmpT + ((size_t)b * 256 + g * 64) * 512;
        const float slope16 = slope2 * 16.0f;
        float m1 = NEGB, l1 = 0.f;
        TL_BEGIN(0, ntc, kcb + (size_t)(64 * ti + lrow) * 256 + lc * 8, kcb)
                f32x16 s0, s1; qk_tile(s0, s1, Kb, KP64, qf, r32, hi);
                const int dl = 64 * ti + 4 * hi;
                const int nmax = (tq - 31) >> 4;
                float mx = NEGB;
#pragma unroll
                for (int r = 0; r < 16; ++r) { const int n0 = dl + ((r & 3) + 8 * (r >> 2)), n1 = n0 + 32;
                    s0[r] = n0 <= nmax ? fmaf(slope16, CRF(r), s0[r]) : NEGB; s1[r] = n1 <= nmax ? fmaf(slope16, CRF(r), s1[r]) : NEGB;
                    mx = fmaxf(mx, fmaxf(s0[r], s1[r] + 32.0f * slope16)); }
                const float base = slope2 * (float)(16 * dl + 31 - tq);
                mx = fmaxf(mx + base, __shfl_xor(mx + base, 32));
                const float mn = fmaxf(m1, mx); float sum = 0.f;
                const float sub0 = mn - base, sub1 = sub0 - 32.0f * slope16;
#pragma unroll
                for (int r = 0; r < 16; ++r) sum += ex2(s0[r] - sub0) + ex2(s1[r] - sub1);
                l1 = l1 * ex2(m1 - mn) + sum; m1 = mn;
        TL_END
        l1 += __shfl_xor(l1, 32);
        const float inv1 = (tq >= 31) ? 1.0f / l1 : 0.f;
        float g0, g1, g2;
        { const bf16* gp = P + mq * NSA_PITCH + 2560 + 3 * h;
          g0 = 1.0f / (1.0f + __expf(-bf2f(gp[0]))); g1 = 1.0f / (1.0f + __expf(-bf2f(gp[1]))); g2 = 1.0f / (1.0f + __expf(-bf2f(gp[2]))); }
        LAS float* totl = (LAS float*)(lds + NSA_LDS_TOT + wave * 8192) + lane;
        {
            f32x16 oc[2]; oc[0] = zero16(); oc[1] = zero16();
            TL_BEGIN(1, ntc, kcb + (size_t)(64 * ti + lrow) * 256 + lc * 8, vcb + (size_t)lrow * 512 + 64 * ti + lc * 8)
                    f32x16 s0, s1; qk_tile(s0, s1, Kb, KP64, qf, r32, hi);
                    const int dl = 64 * ti + 4 * hi;
                    const int nmax = (tq - 31) >> 4;
                    const float sub0 = m1 - slope2 * (float)(16 * dl + 31 - tq), sub1 = sub0 - 32.0f * slope16;
#pragma unroll
                    for (int r = 0; r < 16; ++r) { const int n0 = dl + ((r & 3) + 8 * (r >> 2)), n1 = n0 + 32;
                        s0[r] = n0 <= nmax ? ex2(fmaf(slope16, CRF(r), s0[r]) - sub0) * inv1 : 0.f; s1[r] = n1 <= nmax ? ex2(fmaf(slope16, CRF(r), s1[r]) - sub1) * inv1 : 0.f; }
#pragma unroll
                    for (int bk = 0; bk < 2; ++bk)
#pragma unroll
                        for (int j = 0; j < 4; ++j) {
                            const f32x16& s = bk ? s1 : s0;
                            const int sb = 16 * ti + 8 * bk + 2 * j + hi;
                            const float gs = (s[4 * j] + s[4 * j + 1]) + (s[4 * j + 2] + s[4 * j + 3]);
                            if (sb <= qb) __hip_atomic_fetch_add(&imp[ql * 129 + sb], (unsigned)(gs * IMP_FIX + 0.5f), __ATOMIC_RELAXED, __HIP_MEMORY_SCOPE_WORKGROUP);
                            if (sb + 1 <= qb) __hip_atomic_fetch_add(&imp[ql * 129 + sb + 1], (unsigned)(s[4 * j + 3] * IMP_FIX + 0.5f), __ATOMIC_RELAXED, __HIP_MEMORY_SCOPE_WORKGROUP);
                        }
                    bf16x8 pf[4]; pack_p(pf, s0, s1); pv_tile<2>(oc, Vb, pf, r32, hi);
            TL_END
#pragma unroll
            for (int db = 0; db < 2; ++db)
#pragma unroll
                for (int r = 0; r < 16; ++r) totl[(db * 16 + r) * 64] = oc[db][r] * g0;
        }
        unsigned mk0, mk1, mk2, mk3; unsigned long long ulo, uhi;
        if (qb < 16) { mk0 = (2u << qb) - 1u; mk1 = mk2 = mk3 = 0u; ulo = mk0; uhi = 0ull; }
        else {
            const int s0i = lane, s1i = lane + 64;
            const bool c0 = s0i >= 1 && s0i <= qb - 2, c1 = s1i <= qb - 2;
            { const int i4 = 0;
                int v0[8], v1[8], thr[8];
#pragma unroll
                for (int k = 0; k < 8; ++k) { const int q = wave * 8 + i4 + k;
                    v0[k] = c0 ? (int)imp[q * 129 + s0i] : -1; v1[k] = c1 ? (int)imp[q * 129 + s1i] : -1; thr[k] = 0; }
#pragma unroll 1
                for (int bit = 30; bit >= 0; --bit) {
                    unsigned long long bm0[8], bm1[8];
#pragma unroll
                    for (int k = 0; k < 8; ++k) { const int cand = thr[k] | (1 << bit); bm0[k] = __ballot(v0[k] >= cand); bm1[k] = __ballot(v1[k] >= cand); }
#pragma unroll
                    for (int k = 0; k < 8; ++k) { const int c = __builtin_popcountll(bm0[k]) + __builtin_popcountll(bm1[k]);
                        thr[k] = c >= 13 ? (thr[k] | (1 << bit)) : thr[k]; }
                }
#pragma unroll
                for (int k = 0; k < 8; ++k) { const int q = wave * 8 + i4 + k;
                    const bool gt0 = v0[k] > thr[k], gt1 = v1[k] > thr[k], eq0 = v0[k] == thr[k], eq1 = v1[k] == thr[k];
                    const int need = 13 - (__builtin_popcountll(__ballot(gt0)) + __builtin_popcountll(__ballot(gt1)));
                    const unsigned long long be0 = __ballot(eq0), be1 = __ballot(eq1), lm = (1ull << lane) - 1ull;
                    const int re0 = __builtin_popcountll(be0 & lm), re1 = __builtin_popcountll(be0) + __builtin_popcountll(be1 & lm);
                    const bool sel0 = gt0 || (eq0 && re0 < need) || s0i == 0 || s0i == qb || s0i == qb - 1;
                    const bool sel1 = gt1 || (eq1 && re1 < need) || s1i == qb || s1i == qb - 1;
                    const unsigned long long b0 = __ballot(sel0), b1 = __ballot(sel1);
                    if (lane == 0) { masks[q * 4 + 0] = (unsigned)b0; masks[q * 4 + 1] = (unsigned)(b0 >> 32); masks[q * 4 + 2] = (unsigned)b1; masks[q * 4 + 3] = (unsigned)(b1 >> 32); } }
            }
            __syncthreads();
            mk0 = masks[ql * 4 + 0]; mk1 = masks[ql * 4 + 1]; mk2 = masks[ql * 4 + 2]; mk3 = masks[ql * 4 + 3];
            unsigned u0 = masks[lane * 4 + 0], u1 = masks[lane * 4 + 1], u2 = masks[lane * 4 + 2], u3 = masks[lane * 4 + 3];
#pragma unroll
            for (int o = 1; o < 64; o <<= 1) { u0 |= __shfl_xor(u0, o); u1 |= __shfl_xor(u1, o); u2 |= __shfl_xor(u2, o); u3 |= __shfl_xor(u3, o); }
            u0 = __builtin_amdgcn_readfirstlane(u0); u1 = __builtin_amdgcn_readfirstlane(u1); u2 = __builtin_amdgcn_readfirstlane(u2); u3 = __builtin_amdgcn_readfirstlane(u3);
            ulo = (unsigned long long)u0 | ((unsigned long long)u1 << 32); uhi = (unsigned long long)u2 | ((unsigned long long)u3 << 32);
        }
        const int nsel = __builtin_popcountll(ulo) + __builtin_popcountll(uhi);
        if (tid < 128) {
            const unsigned long long w = tid < 64 ? ulo : uhi; const int sb = tid & 63;
            if ((w >> sb) & 1ull) blist[__builtin_popcountll(w & ((1ull << sb) - 1ull)) + (tid < 64 ? 0 : __builtin_popcountll(ulo))] = tid;
        }
        __syncthreads();
        {
            f32x16 os[2]; os[0] = zero16(); os[1] = zero16(); float m2 = NEGB, l2 = 0.f;
            const bf16* ksb = P + (size_t)b * T * NSA_PITCH + 1536 + g * 64;
            TL_BEGIN(2, nsel, ksb + (size_t)(64 * blist[ti] + lrow) * NSA_PITCH + lc * 8, ksb + 256 + (size_t)(64 * blist[ti] + lrow) * NSA_PITCH + lc * 8)
                    const int s = blist[ti];
                    const unsigned wsel = s < 32 ? mk0 : (s < 64 ? mk1 : (s < 96 ? mk2 : mk3));
                    const bool selb = (wsel >> (s & 31)) & 1u;
                    if (__any(selb)) {
                        f32x16 s0, s1; qk_tile(s0, s1, Kb, KP64, qf, r32, hi);
                        v4i16_t vf[16]; vtr_issue<2>(vf, Vb, lane, hi);
                        const int dl = 64 * s - tq + 4 * hi; float a0, a1;
                        if (s < qb) bias_mask<0>(s0, s1, slope2, dl, a0, a1); else bias_mask<1>(s0, s1, slope2, dl, a0, a1);
                        softmax_fast<2>(s0, s1, a0, a1, slope2 * (float)dl, c32, selb, m2, l2, os);
                        bf16x8 pf[4]; pack_p(pf, s0, s1);
                        LGKM_WAIT_SB(); vtr_mfma<2>(os, vf, pf);
                    }
            TL_END
            l2 += __shfl_xor(l2, 32);
            const float w = g1 / l2;
#pragma unroll
            for (int db = 0; db < 2; ++db)
#pragma unroll
                for (int r = 0; r < 16; ++r) totl[(db * 16 + r) * 64] += os[db][r] * w;
        }
        {
            f32x16 ow[2]; ow[0] = zero16(); ow[1] = zero16(); float m3 = NEGB, l3 = 0.f;
            const int ntw = (qb < 8 ? qb : 8) + 1;
            const bf16* kwb = P + (size_t)b * T * NSA_PITCH + 2048 + g * 64;
            TL_BEGIN(2, ntw, kwb + (size_t)(64 * (qb - ti) + lrow) * NSA_PITCH + lc * 8, kwb + 256 + (size_t)(64 * (qb - ti) + lrow) * NSA_PITCH + lc * 8)
                    f32x16 s0, s1; qk_tile(s0, s1, Kb, KP64, qf, r32, hi);
                    v4i16_t vf[16]; vtr_issue<2>(vf, Vb, lane, hi);
                    const int dl = 64 * (qb - ti) - tq + 4 * hi; float a0, a1;
                    if (ti == 0) bias_mask<1>(s0, s1, slope2, dl, a0, a1); else if (ti == 8) bias_mask<2>(s0, s1, slope2, dl, a0, a1); else bias_mask<0>(s0, s1, slope2, dl, a0, a1);
                    softmax_fast<2>(s0, s1, a0, a1, slope2 * (float)dl, c32, true, m3, l3, ow);
                    bf16x8 pf[4]; pack_p(pf, s0, s1);
                    LGKM_WAIT_SB(); vtr_mfma<2>(ow, vf, pf);
            TL_END
            l3 += __shfl_xor(l3, 32);
            const float w = g2 / l3;
#pragma unroll
            for (int db = 0; db < 2; ++db)
#pragma unroll
                for (int r = 0; r < 16; ++r) ow[db][r] = totl[(db * 16 + r) * 64] + ow[db][r] * w;
            store_ot<2>(O + mq * D + h * 64, ow, hi);
        }
    }
}

constexpr int SB_LDS_FLAGS = 4 * TILE64;
constexpr float SB_STOP = 152.0f;
__device__ __forceinline__ void sb_attn_phase(const bf16* QK, const bf16* VT, bf16* O, lds_u8* lds, int G, int bid, int tid) {
    const int wave = tid >> 6, lane = tid & 63, r32 = lane & 31, hi = lane >> 5;
    const int lrow = tid >> 3, lc = tid & 7;
    LAS int* flags = (LAS int*)(lds + SB_LDS_FLAGS);
    for (int ui = bid; ui < 1024; ui += G) {
        const int bh = ui & 31, b = bh >> 4, h = bh & 15, qblk = ui >> 5;
        const int t0 = 256 * qblk, tw0 = t0 + 32 * wave, tq = tw0 + r32;
        const size_t mq = (size_t)b * T + tq;
        bf16x8 qf[4];
#pragma unroll
        for (int ks = 0; ks < 4; ++ks) qf[ks] = *(const bf16x8*)(QK + mq * QK_PITCH + h * 64 + 16 * ks + 8 * hi);
        const bf16* kb = QK + (size_t)b * T * QK_PITCH + 1024 + h * 64 + lc * 8;
        const bf16* vb = VT + (size_t)(h * 64 + lrow) * VT_PITCH + (size_t)b * T + lc * 8;
        const int nt = 4 * qblk + 4;
        f32x16 o[2]; o[0] = zero16(); o[1] = zero16();
        float R = 0.f; int done = 0;
        u32x4 kr = *(const u32x4*)(kb + (size_t)(64 * (nt - 1) + lrow) * QK_PITCH), vr = *(const u32x4*)(vb + 64 * (nt - 1));
        for (int i = 0; i < nt; ++i) {
            const int key0 = 64 * (nt - 1 - i);
            lds_u8* Kb = lds + (i & 1) * TILE64; lds_u8* Vb = lds + 2 * TILE64 + (i & 1) * TILE64;
            st_k64(Kb, kr, tid); st_vt64(Vb, vr, lrow, lc);
            if (lane == 0) flags[(i & 1) * 8 + wave] = done;
            __syncthreads();
            int alld = 1;
#pragma unroll
            for (int w = 0; w < 8; ++w) alld &= flags[(i & 1) * 8 + w];
            if (alld) break;
            if (i + 1 < nt) { kr = *(const u32x4*)(kb + (size_t)(key0 - 64 + lrow) * QK_PITCH); vr = *(const u32x4*)(vb + key0 - 64); }
            if (!done && key0 < tw0 + 31) {
                f32x16 s0, s1; qk_tile(s0, s1, Kb, KP64, qf, r32, hi);
                f32x16 sp0, sp1;
                const int db = key0 - tq;
#pragma unroll
                for (int r = 0; r < 16; ++r) { const int d0 = db + crow(r, hi), d1 = d0 + 32;
                    const float z0 = s0[r], z1 = s1[r];
                    sp0[r] = d0 < 0 ? fmaxf(z0, 0.f) + lg2(1.0f + ex2(-fabsf(z0))) : 0.f;
                    sp1[r] = d1 < 0 ? fmaxf(z1, 0.f) + lg2(1.0f + ex2(-fabsf(z1))) : 0.f; }
                float gs[8], pg[8], SP[8];
#pragma unroll
                for (int p = 0; p < 8; ++p) { const f32x16& s = (p < 4) ? sp0 : sp1; const int j = p & 3;
                    gs[p] = (s[4 * j] + s[4 * j + 1]) + (s[4 * j + 2] + s[4 * j + 3]); pg[p] = __shfl_xor(gs[p], 32); }
                float run = 0.f;
#pragma unroll
                for (int p = 7; p >= 0; --p) { SP[p] = run; run += gs[p] + pg[p]; }
#pragma unroll
                for (int p = 0; p < 8; ++p) {
                    const int j = p & 3; const int dbase = db + (p < 4 ? 0 : 32);
                    float exc = R + SP[p] + (hi == 0 ? pg[p] : 0.f);
#pragma unroll
                    for (int e = 3; e >= 0; --e) {
                        const int r = 4 * j + e; const int d = dbase + crow(r, hi);
                        const float z = (p < 4) ? s0[r] : s1[r], sp = (p < 4) ? sp0[r] : sp1[r];
                        const float a = d < 0 ? ex2(z - sp - exc) : 0.f;
                        exc += sp;
                        if (p < 4) s0[r] = a; else s1[r] = a;
                    }
                }
                R += run;
                bf16x8 pf[4]; pack_p(pf, s0, s1); pv_tile<2>(o, Vb, pf, r32, hi);
                done = __all(R > SB_STOP) ? 1 : 0;
            }
        }
        __syncthreads();
        store_ot<2>(O + mq * D + h * 64, o, hi);
    }
}

__device__ __forceinline__ void knorm_phase(const bf16* QK, unsigned* kmax  , int G, int bid, int tid) {
    const int wave = tid >> 6, lane = tid & 63;
    const int gw = bid * NWAVES + wave, NGW = G * NWAVES;
    float best = 0.f; int bcur = -1;
    for (int m = gw; m < M; m += NGW) {
        const int b = m / T;
        if (b != bcur) { if (bcur >= 0 && (lane & 3) == 0) atomicMax(kmax + bcur * 16 + (lane >> 2), __float_as_uint(best)); best = 0.f; bcur = b; }
        const u32x4* kp = (const u32x4*)(QK + (size_t)m * QK_PITCH + 1024 + 16 * lane);
        const u32x4 a = kp[0], c = kp[1]; float s = 0.f;
        const unsigned w[8] = {a.x, a.y, a.z, a.w, c.x, c.y, c.z, c.w};
#pragma unroll
        for (int i = 0; i < 8; ++i) { const float lo = __uint_as_float(w[i] << 16), hi2 = __uint_as_float(w[i] & 0xffff0000u); s += lo * lo + hi2 * hi2; }
        s += __shfl_xor(s, 1); s += __shfl_xor(s, 2);
        best = fmaxf(best, s);
    }
    if (bcur >= 0 && (lane & 3) == 0) atomicMax(kmax + bcur * 16 + (lane >> 2), __float_as_uint(best));
}

constexpr int DF_KT = 64 * KPA128, DF_VT = 128 * KP64, DF_FLAGS = 2 * DF_KT + 2 * DF_VT, DF_SLOT = DF_FLAGS + 64;
__device__ __forceinline__ void diff_attn_phase(const bf16* QK, const bf16* VT, bf16* O, const float* lam, const float* subg, float lam_init, const unsigned* kmaxp, unsigned* ctr,
                                                lds_u8* lds, int G, int bid, int tid) {
    const int wave = tid >> 6, lane = tid & 63, r32 = lane & 31, hi = lane >> 5;
    const float lam_full = __expf(wave_sum(lam[lane] * lam[64 + lane])) - __expf(wave_sum(lam[128 + lane] * lam[192 + lane])) + lam_init;
    LAS float* exch = (LAS float*)lds;
    LAS int* flags = (LAS int*)(lds + DF_FLAGS);
    LAS int* slot = (LAS int*)(lds + DF_SLOT);
    const int x0 = (int)xb_xcc_id() & 7;
    int qk_i = 0, xq = x0;
    for (;;) {
        if (tid == 0) { int got = -1, xs = xq, kk = qk_i;
            for (; kk < 8; ++kk) { xs = (x0 + kk) & 7; const unsigned j = atomicAdd(ctr + xs, 1u); if (j < 128u) { got = (int)j; break; } }
            slot[0] = got; slot[1] = xs; slot[2] = kk; }
        __syncthreads();
        const int ui = slot[0]; xq = slot[1]; qk_i = slot[2];
        __syncthreads();
        if (ui < 0) break;
        const int qblk = 63 - (ui >> 1), b = xq & 1, h = (ui & 1) ? (xq >> 1) : 7 - (xq >> 1);
        const int mm = wave & 1, qsub = wave >> 1, t0 = 128 * qblk, tw0 = t0 + 32 * qsub, tq = tw0 + r32;
        const size_t mq = (size_t)b * T + tq;
        const float slope2 = ex2(-(float)(h + 1)) * LOG2E;
        const bf16x8 qx = alibi_qfrag(slope2, hi);
        bf16x8 qf[4]; float qn = 0.f;
#pragma unroll
        for (int ks = 0; ks < 4; ++ks) { qf[ks] = *(const bf16x8*)(QK + mq * QK_PITCH + h * 128 + mm * 64 + 16 * ks + 8 * hi);
#pragma unroll
            for (int e = 0; e < 8; ++e) { const float v = bf2f((unsigned short)qf[ks][e]); qn += v * v; } }
        qn += __shfl_xor(qn, 32);
        const float qk_bound = sqrtf(qn) * sqrtf(__uint_as_float(kmaxp[b * 16 + h * 2 + mm])) * 1.001f + 0.01f;
        const bf16* kb = QK + (size_t)b * T * QK_PITCH + 1024 + h * 128;
        const bf16* vb = VT + (size_t)(h * 128) * VT_PITCH + (size_t)b * T;
        const int nt = 2 * qblk + 2;
        f32x16 o[4]; o[0] = zero16(); o[1] = zero16(); o[2] = zero16(); o[3] = zero16();
        f32x16 negm = zero16();
        float m = 0.f, l = 0.f; int dead = 0, started = 0;
        u32x4 krA[2], vrA[2], krB[2], vrB[2];
#define DF_LOAD(KR, VR, KEY0) do { _Pragma("unroll") for (int i2 = 0; i2 < 2; ++i2) { const int idx = tid + 512 * i2; \
            KR[i2] = *(const u32x4*)(kb + (size_t)((KEY0) + (idx >> 4)) * QK_PITCH + (idx & 15) * 8); \
            VR[i2] = *(const u32x4*)(vb + (size_t)(idx >> 3) * VT_PITCH + (KEY0) + (idx & 7) * 8); } } while (0)
        DF_LOAD(krA, vrA, 64 * (nt - 1));
        DF_LOAD(krB, vrB, 64 * (nt - 2));
        bool stop = false;
        for (int i = 0; i < nt && !stop; i += 2) {
#pragma unroll
          for (int hh = 0; hh < 2; ++hh) { const int it = i + hh; if (it < nt && !stop) {
            u32x4 (&kr)[2] = hh ? krB : krA; u32x4 (&vr)[2] = hh ? vrB : vrA;
            const int key0 = 64 * (nt - 1 - it);
            lds_u8* Kb = lds + hh * DF_KT; lds_u8* Vb = lds + 2 * DF_KT + hh * DF_VT;
#pragma unroll
            for (int i2 = 0; i2 < 2; ++i2) { const int idx = tid + 512 * i2;
                *(LAS u32x4*)(Kb + (idx >> 4) * KPA128 + (idx & 15) * 16) = kr[i2];
                st_vt64(Vb, vr[i2], idx >> 3, idx & 7); }
            if (tid < 64) st_kextra(Kb + tid * KPA128 + 256, key0 + tid);
            if (started && !dead) {
                const float bound = qk_bound + slope2 * (float)(key0 + 63);
                dead = __all(bound - m < -175.0f) ? 1 : 0;
            }
            if (lane == 0) flags[hh * 8 + wave] = dead;
            __syncthreads();
            int alld = 1;
#pragma unroll
            for (int w = 0; w < 8; ++w) alld &= flags[hh * 8 + w];
            if (alld) { stop = true; }
            else {
            if (it + 2 < nt) DF_LOAD(kr, vr, key0 - 128);
            if (key0 <= tw0 + 31 && !dead) {
                started = 1;
                f32x16 s0, s1; qk_tile5(s0, s1, Kb, KPA128, mm * 128, 256, qf, qx, negm, r32, hi);
                if (key0 + 63 > tw0) {
                    const int dl = key0 - tq + 4 * hi;
#pragma unroll
                    for (int r = 0; r < 16; ++r) { const int d0 = dl + ((r & 3) + 8 * (r >> 2));
                        s0[r] = d0 <= 0 ? s0[r] : NEGB; s1[r] = d0 + 32 <= 0 ? s1[r] : NEGB; }
                }
                softmax_rel<4>(s0, s1, m, negm, l, o);
                bf16x8 pf[4]; pack_p(pf, s0, s1); pv_tile<4>(o, Vb, pf, r32, hi);
            }
            }
          } }
        }
        __syncthreads();
        l += __shfl_xor(l, 32);
        const float inv = 1.0f / l;
        if (mm == 1) {
#pragma unroll
            for (int db = 0; db < 4; ++db)
#pragma unroll
                for (int r = 0; r < 16; ++r) exch[(qsub * 128 + 32 * db + crow(r, hi)) * 33 + r32] = o[db][r] * inv;
        }
        __syncthreads();
        if (mm == 0) {
            float ssq = 0.f;
#pragma unroll
            for (int db = 0; db < 4; ++db)
#pragma unroll
                for (int r = 0; r < 16; ++r) { const float v = o[db][r] * inv - lam_full * exch[(qsub * 128 + 32 * db + crow(r, hi)) * 33 + r32]; o[db][r] = v; ssq += v * v; }
            ssq += __shfl_xor(ssq, 32);
            const float rstd = rsqrtf(ssq * (1.0f / 128.0f) + EPS) * (1.0f - lam_init);
#pragma unroll
            for (int db = 0; db < 4; ++db)
#pragma unroll
                for (int r = 0; r < 16; ++r) o[db][r] *= rstd * subg[32 * db + crow(r, hi)];
            store_ot<4>(O + mq * D + h * 128, o, hi);
        }
        __syncthreads();
    }
}
#ifndef DUP_MASK
#define DUP_MASK 0
#endif
enum StepType { ST_GEMM_SWIGLU = 0, ST_GEMM_F32 = 1, ST_ROW = 2, ST_GEMM_BF16 = 3, ST_COMPRESS = 4, ST_NSA = 5, ST_SB = 6, ST_DIFF = 7, ST_KNORM = 8 };

__global__ void __launch_bounds__(NWAVES * 64, 2) mega_fwd(Args A) {
    extern __shared__ __attribute__((aligned(16))) unsigned char lds_raw[];
    lds_u8* lds = (lds_u8*)lds_raw;
    cg::grid_group grid = cg::this_grid();
    const int wave = __builtin_amdgcn_readfirstlane(threadIdx.x >> 6);
    const int G = gridDim.x, bid = blockIdx.x;
    unsigned char* ws = A.ws;
    const float* modb = (const float*)(ws + WS_MOD);
    bf16* HH = (bf16*)(ws + WS_HH);
    LAS unsigned long long* larg = (LAS unsigned long long*)(lds + LDS_BYTES - 256);
    if (threadIdx.x == 0) { larg[0] = (unsigned long long)A.in[4]; larg[1] = (unsigned long long)A.in[10]; larg[2] = (unsigned long long)A.in[15]; larg[3] = (unsigned long long)A.in[16];
                            larg[4] = (unsigned long long)A.out; larg[5] = (unsigned long long)A.ws; }
#define LARG(T, i) ((T)(((unsigned long long)__builtin_amdgcn_readfirstlane((unsigned)(larg[i] >> 32)) << 32) | (unsigned long long)__builtin_amdgcn_readfirstlane((unsigned)larg[i])))
    bool last_phase = false;
    volatile LAS unsigned* bar_st = (volatile LAS unsigned*)(lds + LDS_BYTES - 64);
    if (threadIdx.x < 2) bar_st[threadIdx.x] = 0u;
    __syncthreads();
    XcdBarrier bar = xcd_barrier_post((unsigned*)(ws + WS_BAR), bar_st);
#define RUN_PH (true)
#define END_PH do { if (!last_phase) { XcdBarrier bb_; bb_.bar = bar.bar; bb_.x = xb_xcc_id(); bb_.st = bar.st; xcd_barrier(bb_); } } while (0)

    if (RUN_PH) { for (int rep = 0; rep < (((DUP_MASK >> 8) & 1) ? 2 : 1); ++rep) p0_prologue(A, lds, bid * NWAVES + wave, G * NWAVES, wave, threadIdx.x & 63, -1, -1); }
    if (A.ph_lo < 0) { asm volatile("s_waitcnt vmcnt(0)" ::: "memory"); __threadfence(); grid.sync(); __threadfence(); }
    END_PH;
    if (RUN_PH) p0_reduce(A, G, bid, threadIdx.x);
    END_PH;
    if (RUN_PH) row_phase(A.in[0], nullptr, nullptr, (bf16*)(ws + WS_XB), HH, nullptr, 0, nullptr, 0.f, modb, 0, A.in[4], G, bid, wave, threadIdx.x & 63);
    END_PH;

#pragma unroll 1
    for (int l = 0; l < DEPTH; ++l) {
        const int kind = l % 3, jn = l / 3;
#pragma unroll 1
        for (int sidx = 0; sidx < 3; ++sidx) {
            const int nsteps = (sidx != 1) ? 2 : (kind == 1 ? 3 : 4);
#pragma unroll 1
            for (int st = 0; st < nsteps; ++st) {
                int type;
                if (st == nsteps - 1) type = ST_GEMM_F32;
                else if (st == 0) type = (sidx != 1) ? ST_GEMM_SWIGLU : ST_GEMM_BF16;
                else if (kind == 0) type = (st == 1) ? ST_COMPRESS : ST_NSA;
                else if (kind == 1) type = ST_SB;
                else type = (st == 1) ? ST_KNORM : ST_DIFF;
                last_phase = (l == DEPTH - 1 && sidx == 2 && st == nsteps - 1);
#if DUP_MASK
#pragma unroll 1
                for (int rep = 0; rep < (((DUP_MASK >> type) & 1) ? 2 : 1); ++rep)
#define REP_IDX rep
#else
#define REP_IDX 0
#endif
                {
                    int tid = threadIdx.x; asm volatile("" : "+v"(tid));
                    unsigned char* ws = A.ws; float* xout = A.out; const float* norm_g = A.in[4];
                    const float* modb = (const float*)(ws + WS_MOD);
                    bf16* HH = (bf16*)(ws + WS_HH); bf16* Hb = (bf16*)(ws + WS_H); bf16* VT = (bf16*)(ws + WS_VT); bf16* Ob = (bf16*)(ws + WS_O);
                    bf16* kcmp = (bf16*)(ws + WS_KCMP); bf16* vcmpT = (bf16*)(ws + WS_VCMPT);
                    if (type == ST_GEMM_SWIGLU) {
                        const int f = sidx >> 1;
                        pg8::Gemm g{HH, (const bf16*)(ws + WS_W1T) + (size_t)(l * 2 + f) * 2 * DFF * D, M, 2 * DFF, D};
                        pg8::StaticOrder S; S.init(M, 2 * DFF, G, bid);
                        pg8::EpiSwiglu E{Hb, DFF};
                        pg8::gemm_phase<pg8::EpiSwiglu, pg8::StaticOrder, true, true>(lds, g, S, E);
                    } else if (type == ST_GEMM_F32) {
                        pg8::StaticOrder S; S.init(M, D, G, bid);
                        const int l2 = sidx < 2 ? l : l + 1, s2 = sidx < 2 ? sidx + 1 : 0;
                        const bool has_next = l2 < DEPTH;
                        const int lq = has_next ? l2 : 0;
                        int sv = sidx; asm volatile("" : "+s"(sv));
                        pg8::EpiNormResNorm E{uni_ptr((bf16*)(ws + WS_XB)), uni_ptr(has_next ? (float*)nullptr : xout), uni_ptr(has_next ? HH : (bf16*)nullptr), uni_ptr(modb + (size_t)l * 2 * 9216 + (sidx * 3 + 2) * D), uni_ptr(norm_g + (size_t)(l * 6 + 2 * sidx + 1) * D), uni_f(sv == 1 ? 1.0f : 0.5f),
                                              uni_ptr(modb + (size_t)lq * 2 * 9216 + (s2 * 3) * D), uni_ptr(norm_g + (size_t)(lq * 6 + 2 * s2) * D),
                                              uni_ptr((float*)(ws + WS_XSLOT)), uni_ptr((unsigned*)(ws + WS_PCNT)), uni_u(64u * (unsigned)(l * 3 + sidx) + 32u)};
                        const bf16* Ap; const bf16* Bp; int Kg;
                        if (sidx != 1) { Ap = Hb; Bp = (const bf16*)(ws + WS_W2T) + (size_t)(l * 2 + (sidx >> 1)) * D * DFF; Kg = DFF; }
                        else { Ap = Ob; Kg = D; Bp = kind == 0 ? (const bf16*)(ws + WS_NSAOUT) + (size_t)jn * D * D : (kind == 1 ? (const bf16*)(ws + WS_SBOUT) : (const bf16*)(ws + WS_DFOUT)); }
                        pg8::Gemm g{Ap, Bp, M, D, Kg};
                        pg8::gemm_phase<pg8::EpiNormResNorm, pg8::StaticOrder, false, true>(lds, g, S, E);
                    } else if (type == ST_GEMM_BF16) {
                        const bf16* Win = kind == 0 ? (const bf16*)(ws + WS_NSAIN) + (size_t)jn * NSA_PITCH * D : (kind == 1 ? (const bf16*)(ws + WS_SBIN) : (const bf16*)(ws + WS_DFIN));
                        const int nsub = kind == 0 ? 1 : 2;
#pragma unroll 1
                        for (int sg = 0; sg < nsub; ++sg) {
                            const bf16* Ap; const bf16* Bp; int Mg, Ng, ldc, qcols; bf16* Op;
                            if (sg == 0) { Ap = HH; Bp = Win; Mg = M; Ng = kind == 0 ? NSA_PITCH : 2048; Op = Hb; ldc = kind == 0 ? NSA_PITCH : QK_PITCH; qcols = 1024; }
                            else if (kind == 0) { Ap = Win + (size_t)(sg == 1 ? 1792 : 2304) * D; Bp = HH; Mg = 256; Ng = M; Op = VT + (size_t)(sg == 1 ? 0 : 256) * M; ldc = M; qcols = 0; }
                            else { Ap = Win + (size_t)2048 * D; Bp = HH; Mg = 1024; Ng = M; Op = VT; ldc = VT_PITCH; qcols = 0; }
                            pg8::Gemm g{Ap, Bp, Mg, Ng, D};
                            pg8::StaticOrder S; S.init(Mg, Ng, G, bid);
                            pg8::EpiBf16 E{Op, ldc, qcols, QSCALE};
                            pg8::gemm_phase<pg8::EpiBf16, pg8::StaticOrder, true, true>(lds, g, S, E);
                        }
                    } else if (type == ST_COMPRESS) {
                        compress_phase(Hb, (const bf16*)(ws + WS_CMPW1) + (size_t)jn * 2 * 256 * 2048, (const float*)(ws + WS_CMPB) + jn * 512,
                                       A.in[10] + (size_t)jn * 2 * 256 * 64, kcmp, vcmpT, lds, G, bid, tid);
                    } else if (type == ST_NSA) {
                        nsa_attn_phase(Hb, VT, kcmp, vcmpT, Ob, (unsigned*)(ws + WS_CTR) + 64 * l + 16 * REP_IDX, lds, G, bid, tid);
                    } else if (type == ST_SB) {
                        sb_attn_phase(Hb, VT, Ob, lds, G, bid, tid);
                    } else if (type == ST_DIFF) {
                        int lv = l; asm volatile("" : "+s"(lv));
                        const float lam_init = 0.8f - 0.6f * __expf(-0.3f * (float)lv);
                        diff_attn_phase(Hb, VT, Ob, A.in[15], A.in[16], lam_init, (const unsigned*)(ws + WS_KMAX), (unsigned*)(ws + WS_CTR) + 64 * l + 16 * REP_IDX, lds, G, bid, tid);
                    } else if (type == ST_KNORM) {
                        knorm_phase(Hb, (unsigned*)(ws + WS_KMAX), G, bid, tid);
                    }
                }
                END_PH;
            }
        }
    }
}

extern "C" void kernel_launch(void* const* d_in, const int* in_sizes, int n_in, void* d_out, int out_size, void* d_ws, size_t ws_size, hipStream_t stream) {
    static int grid = 0;
    if (grid == 0) {
        if (n_in != 18 || out_size != M * D || ws_size < WS_END) { fprintf(stderr, "kernel_launch: unexpected shapes (n_in %d out %d ws %zu)\n", n_in, out_size, ws_size); grid = -1; return; }
        int dev = 0, cus = 0, per_cu = 0;
        hipGetDevice(&dev);
        hipDeviceGetAttribute(&cus, hipDeviceAttributeMultiprocessorCount, dev);
        hipFuncSetAttribute((const void*)mega_fwd, hipFuncAttributeMaxDynamicSharedMemorySize, LDS_BYTES);
        hipOccupancyMaxActiveBlocksPerMultiprocessor(&per_cu, (const void*)mega_fwd, NWAVES * 64, LDS_BYTES);
        if (per_cu < 1) { fprintf(stderr, "kernel_launch: occupancy query says %d blocks per CU\n", per_cu); per_cu = 1; }
        (void)hipGetLastError();
        grid = cus * per_cu;
    }
    if (grid < 0) return;
    hipMemsetAsync((char*)d_ws + WS_BAR, 0, 64 * 1024, stream);
    Args a{};
    for (int i = 0; i < 18; ++i) a.in[i] = (const float*)d_in[i];
    a.out = (float*)d_out; a.ws = (unsigned char*)d_ws; a.ph_lo = 0; a.ph_hi = 1 << 20;
    void* args[] = {&a};
    hipError_t e = hipLaunchCooperativeKernel((const void*)mega_fwd, dim3(grid), dim3(NWAVES * 64), args, LDS_BYTES, stream);
    if (e != hipSuccess) fprintf(stderr, "cooperative launch failed: %s (grid %d)\n", hipGetErrorString(e), grid);
}
```

```cpp
#include <hip/hip_runtime.h>
#include <hip/hip_cooperative_groups.h>
#include <cstdio>
#include <cstdint>
namespace cg = cooperative_groups;
namespace pg8 {
#define PG8_LAS __attribute__((address_space(3)))
typedef unsigned short bf16_t;
typedef short bf16x8 __attribute__((ext_vector_type(8)));
typedef float f32x4 __attribute__((ext_vector_type(4)));
typedef unsigned u32x4 __attribute__((ext_vector_type(4)));
constexpr int BM = 256, BK = 64, HALF = 128, HTB = HALF * BK * 2  , STAGE_BYTES = 8 * HTB, NXCD = 8, WGM = 8;

__host__ __device__ __forceinline__ int lds_byte(int r, int c) { const int st = (r >> 4) * 2 + (c >> 5), rr = r & 15, cc = c & 31, ob = rr * 64 + cc * 2; return st * 1024 + (ob ^ (((ob >> 9) & 1) << 5)); }
__host__ __device__ __forceinline__ void stage_rc(int b, int& R, int& C) { const int st = b / 1024, sb = b % 1024, swz = sb ^ (((sb >> 9) & 1) << 5); R = (st >> 1) * 16 + swz / 64; C = (st & 1) * 32 + (swz % 64) / 2; }
__host__ __device__ __forceinline__ int perm32(int rho) { const int n = rho >> 4, i = rho & 15; return 8 * (i >> 2) + 4 * n + (i & 3); }

struct Unit { int pm, pn; };
struct Gemm { const bf16_t* A; const bf16_t* Bt; int M, N, K; };

struct StaticOrder {
    int nM, nN, nwg, G, c;
    __host__ __device__ void init(int M, int N, int G_, int c_) { nM = M / BM; nN = N / BM; nwg = nM * nN; G = G_; c = c_; }
    __host__ __device__ bool next(int i, Unit& u) const {
        const long L = (long)i * G + c; if (L >= nwg) return false;
        int wgid = (int)L; { const int q = nwg / NXCD, r = nwg % NXCD, xcd = wgid % NXCD, off = wgid / NXCD; wgid = (xcd < r ? xcd * (q + 1) : r * (q + 1) + (xcd - r) * q) + off; }
        const int nig = WGM * nN, gid = wgid / nig, fm = gid * WGM, gsz = (nM - fm) < WGM ? (nM - fm) : WGM;
        u.pm = fm + ((wgid % nig) % gsz); u.pn = (wgid % nig) / gsz; return true;
    }
    __device__ __forceinline__ void a_ready(const Unit&) const {}
    __device__ __forceinline__ void done(const Unit&) const {}
};

__device__ __forceinline__ unsigned cvt_pk_bf16(float lo, float hi) { unsigned r; asm volatile("v_cvt_pk_bf16_f32 %0, %1, %2" : "=v"(r) : "v"(lo), "v"(hi)); return r; }
typedef float f32x2 __attribute__((ext_vector_type(2)));
typedef _Float16 f16x2 __attribute__((ext_vector_type(2)));
__device__ __forceinline__ unsigned cvt_pk_f16(float lo, float hi) { const f16x2 h = {(_Float16)lo, (_Float16)hi}; return __builtin_bit_cast(unsigned, h); }
__device__ __forceinline__ float f16lo(unsigned w) { return (float)__builtin_bit_cast(f16x2, w)[0]; }
__device__ __forceinline__ float f16hi(unsigned w) { return (float)__builtin_bit_cast(f16x2, w)[1]; }
template <class Epi, class Sched, bool ALIGN_EPI = false, bool SP2 = false>
__device__ __forceinline__ void gemm_phase(PG8_LAS unsigned char* lds, const Gemm g, const Sched& S, const Epi& E) {
    int tid_ = threadIdx.x; asm volatile("" : "+v"(tid_)); const int tid = tid_, wid = __builtin_amdgcn_readfirstlane(tid >> 6), lane = tid & 63, wr = wid >> 2, wc = wid & 3, fr = lane & 15, fq = lane >> 4;
    const int K = g.K, nt = K / BK;
    unsigned voffA[2], voffB[2];
#pragma unroll
    for (int i = 0; i < 2; ++i) { int R, C; stage_rc(tid * 16 + i * 8192, R, C); const int Rb = Epi::PERM ? ((R & ~31) + perm32(R & 31)) : R;
        voffA[i] = (unsigned)(R * K + C) * 2u; voffB[i] = (unsigned)(Rb * K + C) * 2u; }
    const size_t kstep = (size_t)(BK * 2);
    const size_t hstep = (size_t)HALF * K * 2;
    const size_t tstep = 2 * hstep;
    const unsigned ldsw = (unsigned)wid * 1024u;
    const int aoff = lds_byte(wr * 64 + fr, fq * 8), boff = lds_byte(wc * 32 + fr, fq * 8);
#define PG8_SA(b, h) (((b) * 2 + (h)) * HTB)
#define PG8_SB(b, h) ((4 + (b) * 2 + (h)) * HTB)
#define PG8_STAGE(bufoff, gbase, voff) do { _Pragma("unroll") for (int _i = 0; _i < 2; ++_i) \
        __builtin_amdgcn_global_load_lds((const unsigned*)((const char*)(gbase) + (voff)[_i]), (PG8_LAS unsigned*)(lds + (bufoff) + ldsw + _i * 8192), 16, 0, 0); } while (0)
#define PG8_LDA(dst, b, h) do { _Pragma("unroll") for (int m = 0; m < 4; ++m) _Pragma("unroll") for (int k = 0; k < 2; ++k) dst[m][k] = *(const PG8_LAS bf16x8*)(lds + PG8_SA(b, h) + aoff + m * 2048 + k * 1024); } while (0)
#define PG8_LDB(dst, b, h) do { _Pragma("unroll") for (int n = 0; n < 2; ++n) _Pragma("unroll") for (int k = 0; k < 2; ++k) dst[n][k] = *(const PG8_LAS bf16x8*)(lds + PG8_SB(b, h) + boff + n * 2048 + k * 1024); } while (0)
#define PG8_MMA(ai, bj, At, Bt) do { __builtin_amdgcn_s_setprio(1); _Pragma("unroll") for (int m = 0; m < 4; ++m) _Pragma("unroll") for (int n = 0; n < 2; ++n) _Pragma("unroll") for (int k = 0; k < 2; ++k) \
        acc[ai][bj][m][n] = __builtin_amdgcn_mfma_f32_16x16x32_bf16(Bt[n][k], At[m][k], acc[ai][bj][m][n], 0, 0, 0); __builtin_amdgcn_s_setprio(0); } while (0)
#define PG8_WAIT_V(n) asm volatile("s_waitcnt vmcnt(" #n ")" ::: "memory")
#define PG8_WAIT_L(n) asm volatile("s_waitcnt lgkmcnt(" #n ")" ::: "memory")
#define PG8_BAR __builtin_amdgcn_s_barrier()
#define PG8_SCHED __builtin_amdgcn_sched_barrier(0)
    Unit cur, nxt; int ui = 0;
    if (!S.next(0, cur)) return;
    f32x4 acc[2][2][4][2];
#pragma unroll
    for (int a = 0; a < 2; ++a)
#pragma unroll
        for (int b = 0; b < 2; ++b)
#pragma unroll
            for (int m = 0; m < 4; ++m)
#pragma unroll
                for (int n = 0; n < 2; ++n) acc[a][b][m][n] = (f32x4){0.f, 0.f, 0.f, 0.f};
    bf16x8 At[4][2], B0[2][2], B1[2][2];
    const char* cA = (const char*)g.A + (size_t)cur.pm * tstep; const char* cB = (const char*)g.Bt + (size_t)cur.pn * tstep;
    S.a_ready(cur);
    if constexpr (SP2) {
        PG8_STAGE(PG8_SB(0, 0), cB, voffB); PG8_STAGE(PG8_SB(0, 1), cB + hstep, voffB); PG8_STAGE(PG8_SA(0, 0), cA, voffA); PG8_STAGE(PG8_SA(0, 1), cA + hstep, voffA);
        if (wr == 1) PG8_BAR;
        PG8_WAIT_V(2); PG8_BAR;
        PG8_STAGE(PG8_SB(1, 0), cB + kstep, voffB); PG8_STAGE(PG8_SA(1, 0), cA + kstep, voffA); PG8_STAGE(PG8_SB(1, 1), cB + hstep + kstep, voffB);
        PG8_WAIT_V(6); PG8_BAR;
    } else {
        PG8_STAGE(PG8_SB(0, 0), cB, voffB); PG8_STAGE(PG8_SA(0, 0), cA, voffA); PG8_STAGE(PG8_SB(0, 1), cB + hstep, voffB); PG8_STAGE(PG8_SA(0, 1), cA + hstep, voffA);
        if (wr == 1) PG8_BAR;
        PG8_WAIT_V(4); PG8_BAR;
        PG8_STAGE(PG8_SB(1, 0), cB + kstep, voffB); PG8_STAGE(PG8_SA(1, 0), cA + kstep, voffA); PG8_STAGE(PG8_SB(1, 1), cB + hstep + kstep, voffB);
        PG8_WAIT_V(6); PG8_BAR;
    }
    for (;;) {
        const bool has_next = S.next(ui + 1, nxt);
        const char* nA = has_next ? (const char*)g.A + (size_t)nxt.pm * tstep : cA; const char* nB = has_next ? (const char*)g.Bt + (size_t)nxt.pn * tstep : cB;
        for (int t = 0; t < nt; t += 2) {
            const bool last = (t == nt - 2);
            const char* a1 = cA + (size_t)(t + 1) * kstep;
            const char* a2 = last ? nA : cA + (size_t)(t + 2) * kstep; const char* b2 = last ? nB : cB + (size_t)(t + 2) * kstep;
            const char* a3 = a2 + kstep; const char* b3 = b2 + kstep;
            if (last && has_next) S.a_ready(nxt);
            if constexpr (SP2) {
            PG8_LDB(B0, 0, 0); PG8_LDB(B1, 0, 1); PG8_SCHED; PG8_LDA(At, 0, 0); PG8_STAGE(PG8_SA(1, 1), a1 + hstep, voffA);
            PG8_WAIT_V(8); PG8_WAIT_L(0); PG8_BAR; PG8_MMA(0, 0, At, B0); PG8_MMA(0, 1, At, B1); PG8_BAR; PG8_SCHED;
            PG8_LDA(At, 0, 1); PG8_STAGE(PG8_SB(0, 0), b2, voffB); PG8_STAGE(PG8_SB(0, 1), b2 + hstep, voffB); PG8_STAGE(PG8_SA(0, 0), a2, voffA);
            PG8_WAIT_V(8); PG8_WAIT_L(0); PG8_BAR; PG8_MMA(1, 0, At, B0); PG8_MMA(1, 1, At, B1); PG8_BAR; PG8_SCHED;
            PG8_LDB(B0, 1, 0); PG8_LDB(B1, 1, 1); PG8_SCHED; PG8_LDA(At, 1, 0); PG8_STAGE(PG8_SA(0, 1), a2 + hstep, voffA);
            PG8_WAIT_V(8); PG8_WAIT_L(0); PG8_BAR; PG8_MMA(0, 0, At, B0); PG8_MMA(0, 1, At, B1); PG8_BAR; PG8_SCHED;
            PG8_LDA(At, 1, 1); PG8_STAGE(PG8_SB(1, 0), b3, voffB); PG8_STAGE(PG8_SB(1, 1), b3 + hstep, voffB); PG8_STAGE(PG8_SA(1, 0), a3, voffA);
            PG8_WAIT_V(8); PG8_WAIT_L(0); PG8_BAR; PG8_MMA(1, 0, At, B0); PG8_MMA(1, 1, At, B1); PG8_BAR; PG8_SCHED;
            } else {
            PG8_LDB(B0, 0, 0); PG8_SCHED; PG8_LDA(At, 0, 0); PG8_STAGE(PG8_SA(1, 1), a1 + hstep, voffA);
            PG8_WAIT_L(8); PG8_BAR; PG8_WAIT_L(0); PG8_MMA(0, 0, At, B0); PG8_BAR; PG8_SCHED;
            PG8_LDB(B1, 0, 1); PG8_STAGE(PG8_SB(0, 0), b2, voffB);
            PG8_BAR; PG8_WAIT_L(0); PG8_MMA(0, 1, At, B1); PG8_BAR;
            PG8_LDA(At, 0, 1); PG8_STAGE(PG8_SA(0, 0), a2, voffA);
            PG8_BAR; PG8_WAIT_L(0); PG8_MMA(1, 0, At, B0); PG8_BAR; PG8_SCHED;
            PG8_STAGE(PG8_SB(0, 1), b2 + hstep, voffB);
            PG8_WAIT_V(6); PG8_BAR; PG8_MMA(1, 1, At, B1); PG8_BAR;
            PG8_LDB(B0, 1, 0); PG8_SCHED; PG8_LDA(At, 1, 0); PG8_STAGE(PG8_SA(0, 1), a2 + hstep, voffA);
            PG8_WAIT_L(8); PG8_BAR; PG8_WAIT_L(0); PG8_MMA(0, 0, At, B0); PG8_BAR; PG8_SCHED;
            PG8_LDB(B1, 1, 1); PG8_STAGE(PG8_SB(1, 0), b3, voffB);
            PG8_BAR; PG8_WAIT_L(0); PG8_MMA(0, 1, At, B1); PG8_BAR;
            PG8_LDA(At, 1, 1); PG8_STAGE(PG8_SA(1, 0), a3, voffA);
            PG8_BAR; PG8_WAIT_L(0); PG8_MMA(1, 0, At, B0); PG8_BAR; PG8_SCHED;
            PG8_STAGE(PG8_SB(1, 1), b3 + hstep, voffB);
            PG8_WAIT_V(6); PG8_BAR; PG8_MMA(1, 1, At, B1); PG8_BAR;
            }
        }
        if constexpr (ALIGN_EPI) { if (wr == 0) PG8_BAR; }
        if constexpr (!Epi::AFTER_DRAIN) { E(acc, cur, wr, wc, fr, fq); S.done(cur); }
        if (!has_next) break;
#pragma unroll
        for (int a = 0; a < 2; ++a)
#pragma unroll
            for (int b = 0; b < 2; ++b)
#pragma unroll
                for (int m = 0; m < 4; ++m)
#pragma unroll
                    for (int n = 0; n < 2; ++n) acc[a][b][m][n] = (f32x4){0.f, 0.f, 0.f, 0.f};
        cur = nxt; cA = nA; cB = nB; ++ui;
        if constexpr (ALIGN_EPI) { if (wr == 1) PG8_BAR; }
    }
    PG8_WAIT_V(0);
    if constexpr (!ALIGN_EPI) { if (wr == 0) PG8_BAR; }
    PG8_BAR;
    if constexpr (Epi::AFTER_DRAIN) { E.fused(acc, cur, wr, wc, fr, fq, lds, wid, lane); S.done(cur); }
#undef PG8_SA
#undef PG8_SB
#undef PG8_STAGE
#undef PG8_LDA
#undef PG8_LDB
#undef PG8_MMA
#undef PG8_WAIT_V
#undef PG8_WAIT_L
#undef PG8_BAR
#undef PG8_SCHED
}
}
namespace pg8 {
typedef unsigned u32x4e __attribute__((ext_vector_type(4)));
struct EpiSwiglu {
    static constexpr bool PERM = true, AFTER_DRAIN = false;
    bf16_t* H; int ldc;
    __device__ __forceinline__ void operator()(const f32x4 (&acc)[2][2][4][2], const Unit& u, int wr, int wc, int fr, int fq) const {
        const int row0 = u.pm * BM + wr * 64 + fr, col0 = u.pn * HALF + wc * 32 + 8 * fq;
#pragma unroll
        for (int ai = 0; ai < 2; ++ai)
#pragma unroll
            for (int m = 0; m < 4; ++m) {
                float g8[8], u8[8], v[8];
#pragma unroll
                for (int n = 0; n < 2; ++n)
#pragma unroll
                    for (int j = 0; j < 4; ++j) { g8[4 * n + j] = acc[ai][0][m][n][j]; u8[4 * n + j] = acc[ai][1][m][n][j]; }
#pragma unroll
                for (int e = 0; e < 8; ++e) v[e] = __builtin_amdgcn_exp2f(-1.4426950408889634f * g8[e]);
#pragma unroll
                for (int e = 0; e < 8; ++e) v[e] = __builtin_amdgcn_rcpf(1.0f + v[e]);
#pragma unroll
                for (int e = 0; e < 8; ++e) v[e] = (g8[e] * u8[e]) * v[e];
                u32x4e w; w.x = cvt_pk_bf16(v[0], v[1]); w.y = cvt_pk_bf16(v[2], v[3]); w.z = cvt_pk_bf16(v[4], v[5]); w.w = cvt_pk_bf16(v[6], v[7]);
                *(u32x4e*)(H + (size_t)(row0 + ai * HALF + m * 16) * ldc + col0) = w;
            }
    }
};
struct EpiBf16 {
    static constexpr bool PERM = true, AFTER_DRAIN = false;
    bf16_t* O; int ldc; int qcols; float qscale;
    __device__ __forceinline__ void operator()(const f32x4 (&acc)[2][2][4][2], const Unit& u, int wr, int wc, int fr, int fq) const {
        const int row0 = u.pm * BM + wr * 64 + fr, col0 = u.pn * BM + wc * 32 + 8 * fq;
        const float sc = (u.pn * BM < qcols) ? qscale : 1.0f;
#pragma unroll
        for (int ai = 0; ai < 2; ++ai)
#pragma unroll
            for (int m = 0; m < 4; ++m)
#pragma unroll
                for (int bj = 0; bj < 2; ++bj) {
                    const f32x4 v0 = acc[ai][bj][m][0] * sc, v1 = acc[ai][bj][m][1] * sc;
                    u32x4e w; w.x = cvt_pk_bf16(v0[0], v0[1]); w.y = cvt_pk_bf16(v0[2], v0[3]); w.z = cvt_pk_bf16(v1[0], v1[1]); w.w = cvt_pk_bf16(v1[2], v1[3]);
                    *(u32x4e*)(O + (size_t)(row0 + ai * HALF + m * 16) * ldc + col0 + bj * HALF) = w;
                }
    }
};
struct EpiF32 {
    static constexpr bool PERM = true, AFTER_DRAIN = false;
    float* Y; int ldc;
    __device__ __forceinline__ void operator()(const f32x4 (&acc)[2][2][4][2], const Unit& u, int wr, int wc, int fr, int fq) const {
        const int row0 = u.pm * BM + wr * 64 + fr, col0 = u.pn * BM + wc * 32 + 8 * fq;
#pragma unroll
        for (int ai = 0; ai < 2; ++ai)
#pragma unroll
            for (int m = 0; m < 4; ++m)
#pragma unroll
                for (int bj = 0; bj < 2; ++bj) {
                    float* p = Y + (size_t)(row0 + ai * HALF + m * 16) * ldc + col0 + bj * HALF;
                    *(f32x4*)p = acc[ai][bj][m][0]; *(f32x4*)(p + 4) = acc[ai][bj][m][1];
                }
    }
};
__device__ __forceinline__ void panel_rstd(const f32x4 (&v)[2][2][4][2], const Unit& u, int wr, int wc, int fr, int fq, PG8_LAS unsigned char* lds, int wid, int lane,
                                           float* xslots, unsigned* cnt, unsigned want, float eps) {
    PG8_LAS float* P = (PG8_LAS float*)lds;
    PG8_LAS float* S = (PG8_LAS float*)(lds + 4096);
#pragma unroll
    for (int ai = 0; ai < 2; ++ai)
#pragma unroll
        for (int m = 0; m < 4; ++m) {
            float s = 0.f;
#pragma unroll
            for (int bj = 0; bj < 2; ++bj)
#pragma unroll
                for (int n = 0; n < 2; ++n) { const f32x4 x = v[ai][bj][m][n]; s += (x[0] * x[0] + x[1] * x[1]) + (x[2] * x[2] + x[3] * x[3]); }
            s += __shfl_xor(s, 16); s += __shfl_xor(s, 32);
            if (fq == 0) P[(ai * HALF + wr * 64 + m * 16 + fr) * 4 + wc] = s;
        }
    asm volatile("s_waitcnt lgkmcnt(0)" ::: "memory"); __builtin_amdgcn_s_barrier(); asm volatile("" ::: "memory");
    const int row = wid * 32 + (lane & 31);
    if (lane < 32) {
        const float t = (P[row * 4 + 0] + P[row * 4 + 1]) + (P[row * 4 + 2] + P[row * 4 + 3]);
        __hip_atomic_store(xslots + ((size_t)(u.pm * BM + row) * 4 + u.pn), t, __ATOMIC_RELAXED, __HIP_MEMORY_SCOPE_AGENT);
    }
    asm volatile("s_waitcnt vmcnt(0)" ::: "memory");
    if (lane == 0) __hip_atomic_fetch_add(cnt + 64 * u.pm, 1u, __ATOMIC_RELAXED, __HIP_MEMORY_SCOPE_AGENT);
    if (wid == 0) {
        while ((unsigned)__builtin_amdgcn_readfirstlane(__hip_atomic_load(cnt + 64 * u.pm, __ATOMIC_RELAXED, __HIP_MEMORY_SCOPE_AGENT)) < want) __builtin_amdgcn_s_sleep(2);
        __builtin_amdgcn_fence(__ATOMIC_ACQUIRE, "agent");
    }
    asm volatile("s_waitcnt vmcnt(0) lgkmcnt(0)" ::: "memory"); __builtin_amdgcn_s_barrier(); asm volatile("" ::: "memory");
    if (lane < 32) {
        const float* slot = xslots + (size_t)(u.pm * BM + row) * 4;
        const float t = (__hip_atomic_load(slot + 0, __ATOMIC_RELAXED, __HIP_MEMORY_SCOPE_AGENT) + __hip_atomic_load(slot + 1, __ATOMIC_RELAXED, __HIP_MEMORY_SCOPE_AGENT)) +
                        (__hip_atomic_load(slot + 2, __ATOMIC_RELAXED, __HIP_MEMORY_SCOPE_AGENT) + __hip_atomic_load(slot + 3, __ATOMIC_RELAXED, __HIP_MEMORY_SCOPE_AGENT));
        S[row] = 1.0f / sqrtf(t * (1.0f / 1024.0f) + eps);
    }
    asm volatile("s_waitcnt lgkmcnt(0)" ::: "memory"); __builtin_amdgcn_s_barrier(); asm volatile("" ::: "memory");
}
struct EpiNormResNorm {
    static constexpr bool PERM = true, AFTER_DRAIN = true;
    bf16_t* X; float* XF; bf16_t* HH;
    const float* gate; const float* gpost; float res_w;
    const float* shift; const float* gpre;
    float* xbuf; unsigned* cnt; unsigned want1;
    __device__ __forceinline__ void fused(f32x4 (&acc)[2][2][4][2], const Unit& u, int wr, int wc, int fr, int fq, PG8_LAS unsigned char* lds, int wid, int lane) const {
        typedef unsigned u32x4v __attribute__((ext_vector_type(4)));
        const PG8_LAS float* S = (const PG8_LAS float*)(lds + 4096);
        const int col0 = u.pn * BM + wc * 32 + 8 * fq;
        const int b = (u.pm * BM) / 8192;
        bf16_t* X = this->X; float* XF = this->XF; bf16_t* HH = this->HH; const float* gate = this->gate; const float* gpost = this->gpost; float res_w = this->res_w;
        const float* shift = this->shift; const float* gpre = this->gpre; float* xbuf = this->xbuf; unsigned* cnt = this->cnt; unsigned want1 = this->want1;
        asm volatile("" : "+s"(X), "+s"(XF), "+s"(HH), "+s"(gate), "+s"(gpost), "+s"(res_w)); asm volatile("" : "+s"(shift), "+s"(gpre), "+s"(xbuf), "+s"(cnt), "+s"(want1));
        u32x4v pre[2][4][2];
#pragma unroll
        for (int ai = 0; ai < 2; ++ai)
#pragma unroll
            for (int m = 0; m < 4; ++m)
#pragma unroll
                for (int bj = 0; bj < 2; ++bj) pre[ai][m][bj] = *(const u32x4v*)(X + (size_t)(u.pm * BM + ai * HALF + wr * 64 + m * 16 + fr) * 1024 + col0 + bj * HALF);
        panel_rstd(acc, u, wr, wc, fr, fq, lds, wid, lane, xbuf, cnt, want1, 1e-6f);
#pragma unroll
        for (int bj = 0; bj < 2; ++bj)
#pragma unroll
            for (int n = 0; n < 2; ++n) {
                const int c = col0 + bj * HALF + n * 4;
                const f32x4 gg = *(const f32x4*)(gate + (size_t)b * 9216 + c) * *(const f32x4*)(gpost + c) * res_w;
#pragma unroll
                for (int ai = 0; ai < 2; ++ai)
#pragma unroll
                    for (int m = 0; m < 4; ++m) { const int r = ai * HALF + wr * 64 + m * 16 + fr;
                        const unsigned w0 = n ? pre[ai][m][bj].z : pre[ai][m][bj].x, w1 = n ? pre[ai][m][bj].w : pre[ai][m][bj].y;
                        const f32x4 xv = {f16lo(w0), f16hi(w0), f16lo(w1), f16hi(w1)};
                        acc[ai][bj][m][n] = xv + gg * (acc[ai][bj][m][n] * S[r]); }
                asm volatile("" ::: "memory");
            }
        if (HH) panel_rstd(acc, u, wr, wc, fr, fq, lds, wid, lane, xbuf + (size_t)16384 * 4, cnt, want1 + 32u, 1e-6f);
#pragma unroll
        for (int bj = 0; bj < 2; ++bj) {
            const int c = col0 + bj * HALF;
            f32x4 sh[2], sg[2];
#pragma unroll
            for (int n = 0; n < 2; ++n) { sh[n] = (f32x4){0.f, 0.f, 0.f, 0.f}; sg[n] = sh[n];
                if (HH) { sh[n] = *(const f32x4*)(shift + (size_t)b * 9216 + c + 4 * n); sg[n] = (*(const f32x4*)(shift + (size_t)b * 9216 + 1024 + c + 4 * n) + 1.0f) * *(const f32x4*)(gpre + c + 4 * n); } }
#pragma unroll
            for (int ai = 0; ai < 2; ++ai)
#pragma unroll
                for (int m = 0; m < 4; ++m) { const int r = ai * HALF + wr * 64 + m * 16 + fr; const size_t off = (size_t)(u.pm * BM + r) * 1024 + c;
                    const f32x4 x0 = acc[ai][bj][m][0], x1 = acc[ai][bj][m][1];
                    if (XF) { *(f32x4*)(XF + off) = x0; *(f32x4*)(XF + off + 4) = x1; }
                    else { u32x4v w; w.x = cvt_pk_f16(x0[0], x0[1]); w.y = cvt_pk_f16(x0[2], x0[3]); w.z = cvt_pk_f16(x1[0], x1[1]); w.w = cvt_pk_f16(x1[2], x1[3]); *(u32x4v*)(X + off) = w; }
                    if (HH) { const float rs = S[r]; const f32x4 o0 = x0 * rs * sg[0] + sh[0], o1 = x1 * rs * sg[1] + sh[1];
                        u32x4v w; w.x = cvt_pk_bf16(o0[0], o0[1]); w.y = cvt_pk_bf16(o0[2], o0[3]); w.z = cvt_pk_bf16(o1[0], o1[1]); w.w = cvt_pk_bf16(o1[2], o1[3]); *(u32x4v*)(HH + off) = w; } }
            asm volatile("" ::: "memory");
        }
    }
};
}
constexpr int BATCH = 2, T = 8192, D = 1024, M = BATCH * T, DFF = 2816, DEPTH = 4;
constexpr int NSA_PITCH = 2816;
constexpr int QK_PITCH = 2048 + 64;
constexpr int VT_PITCH = 16384 + 64;
constexpr float EPS = 1e-6f;
constexpr float LOG2E = 1.4426950408889634f;
constexpr float QSCALE = 0.125f * LOG2E;
constexpr float NEGB = -1e30f;
constexpr int NWAVES = 8;

constexpr size_t MiB = 1u << 20;
constexpr size_t WS_MOD = 0;
constexpr size_t WS_CMPB = 512 * 1024;
constexpr size_t WS_ZERO_BYTES = 1 * MiB;
constexpr size_t WS_W1T = 1 * MiB;
constexpr size_t WS_W2T = 89 * MiB;
constexpr size_t WS_NSAIN = 133 * MiB;
constexpr size_t WS_NSAOUT = 144 * MiB;
constexpr size_t WS_CMPW1 = 148 * MiB;
constexpr size_t WS_SBIN = 152 * MiB;
constexpr size_t WS_SBOUT = 158 * MiB;
constexpr size_t WS_DFIN = 160 * MiB;
constexpr size_t WS_DFOUT = 166 * MiB;
constexpr size_t WS_HH = 168 * MiB;
constexpr size_t WS_H = 200 * MiB;
constexpr size_t WS_Y = 288 * MiB;
constexpr size_t WS_VT = 288 * MiB;
constexpr size_t WS_XB = 352 * MiB;
constexpr size_t WS_O = 384 * MiB;
constexpr size_t WS_KCMP = 416 * MiB;
constexpr size_t WS_VCMPT = 417 * MiB;
constexpr size_t WS_MODP = 420 * MiB;
constexpr size_t WS_CMPBP = 424 * MiB;
constexpr size_t WS_BAR = 768 * 1024;
constexpr size_t WS_XSLOT = 425 * MiB;
constexpr size_t WS_PCNT = 800 * 1024;
constexpr size_t WS_KMAX = 820 * 1024;
constexpr size_t WS_CTR = 824 * 1024;
constexpr size_t WS_END = 426 * MiB;

constexpr int LDS_BYTES = 147456;

#define LAS __attribute__((address_space(3)))
typedef unsigned short bf16;
typedef short bf16x8 __attribute__((ext_vector_type(8)));
typedef float f32x4 __attribute__((ext_vector_type(4)));
typedef float f32x16 __attribute__((ext_vector_type(16)));
typedef unsigned u32x4 __attribute__((ext_vector_type(4)));
typedef unsigned u32x2 __attribute__((ext_vector_type(2)));
typedef LAS unsigned char lds_u8;

__device__ __forceinline__ unsigned pk2(float lo, float hi) { return pg8::cvt_pk_bf16(lo, hi); }
__device__ __forceinline__ float bf2f(unsigned short v) { return __uint_as_float((unsigned)v << 16); }
__device__ __forceinline__ float ex2(float x) { return __builtin_amdgcn_exp2f(x); }
__device__ __forceinline__ float lg2(float x) { return __builtin_amdgcn_logf(x); }
__device__ __forceinline__ float wave_sum(float v) {
#pragma unroll
    for (int o = 1; o < 64; o <<= 1) v += __shfl_xor(v, o);
    return v;
}
__device__ __forceinline__ int crow(int r, int hi) { return (r & 3) + 8 * (r >> 2) + 4 * hi; }

template <class Tp> __device__ __forceinline__ Tp* uni_ptr(Tp* p) { const unsigned long long v = (unsigned long long)p;
    const unsigned lo = __builtin_amdgcn_readfirstlane((unsigned)v), hi = __builtin_amdgcn_readfirstlane((unsigned)(v >> 32)); return (Tp*)(((unsigned long long)hi << 32) | lo); }
__device__ __forceinline__ float uni_f(float x) { return __uint_as_float(__builtin_amdgcn_readfirstlane(__float_as_uint(x))); }
__device__ __forceinline__ unsigned uni_u(unsigned x) { return __builtin_amdgcn_readfirstlane(x); }

struct Args { const float* in[18]; float* out; unsigned char* ws; int ph_lo, ph_hi; };

__device__ __forceinline__ void transpose_item(const float* W, int ldw, int nvalid, int K, bf16* WT, int k0, int n0, int drow0, LAS float* scr, int lane) {
    const int r8 = lane >> 3, c4 = lane & 7;
#pragma unroll
    for (int i = 0; i < 8; ++i) { const int kk = 8 * i + r8; const int n = n0 + 4 * c4;
        f32x4 v = {0.f, 0.f, 0.f, 0.f};
        if (n < nvalid) v = *(const f32x4*)(W + (size_t)(k0 + kk) * ldw + n);
        LAS float* d = scr + kk * 33 + 4 * c4; d[0] = v.x; d[1] = v.y; d[2] = v.z; d[3] = v.w; }
    asm volatile("s_waitcnt lgkmcnt(0)" ::: "memory");
    const int c = lane & 7;
#pragma unroll
    for (int j = 0; j < 4; ++j) { const int n = (lane >> 3) + 8 * j; const LAS float* s = scr + (8 * c) * 33 + n;
        u32x4 o; o.x = pk2(s[0 * 33], s[1 * 33]); o.y = pk2(s[2 * 33], s[3 * 33]); o.z = pk2(s[4 * 33], s[5 * 33]); o.w = pk2(s[6 * 33], s[7 * 33]);
        *(u32x4*)(WT + (size_t)(drow0 + n) * K + k0 + 8 * c) = o; }
    asm volatile("s_waitcnt lgkmcnt(0)" ::: "memory");
}
__device__ __forceinline__ void transpose_plain(const float* W, int K, int N, int Npad, bf16* WT, int item, LAS float* scr, int lane) {
    const int nblk = Npad / 32, kb = item / nblk, nb = item % nblk;
    transpose_item(W, N, N, K, WT, 64 * kb, 32 * nb, 32 * nb, scr, lane);
}
__device__ __forceinline__ float siluf(float x) { return x * __builtin_amdgcn_rcpf(1.0f + __expf(-x)); }

template <int NB>
__device__ __forceinline__ void gemv_item(const float* W, int ldw, int kbeg, int klen, int n0, const float* svec, int sstride, bool do_silu, const float* bias, float* out, int ostride, int lane) {
    f32x4 a0 = {0.f, 0.f, 0.f, 0.f}, a1 = {0.f, 0.f, 0.f, 0.f};
    const float* wp = W + (size_t)kbeg * ldw + n0 + 4 * lane;
#pragma unroll 16
    for (int k = 0; k < klen; ++k) {
        const f32x4 w = *(const f32x4*)(wp + (size_t)k * ldw);
        float s0 = svec[kbeg + k]; if (do_silu) s0 = siluf(s0);
        a0 += w * s0;
        if (NB == 2) { float s1 = svec[sstride + kbeg + k]; if (do_silu) s1 = siluf(s1); a1 += w * s1; }
    }
    (void)bias;
    float* o = out + n0 + 4 * lane;
    *(f32x4*)o = a0; if (NB == 2) *(f32x4*)(o + ostride) = a1;
}

__device__ __forceinline__ void p0_prologue(const Args& A, LAS unsigned char* lds, int gw, int NGW, int wave, int lane, int lsel, int half) {
    LAS float* scr = (LAS float*)(lds + wave * 16384);
    unsigned char* ws = A.ws;
    constexpr int I_W1 = (D / 64) * (2 * DFF / 32);
    constexpr int I_W2 = (DFF / 64) * (D / 32);
    constexpr int I_NIN = (D / 64) * (NSA_PITCH / 32);
    constexpr int I_SQ = (D / 64) * (D / 32);
    constexpr int I_CW1 = (2048 / 64) * (256 / 32);
    constexpr int I_IN3 = (D / 64) * (3 * D / 32);
    constexpr int I_ADA = DEPTH * 36 * 8;
    constexpr int I_PEB = 4 * 16;
    constexpr int NITEMS = 8 * I_W1 + 8 * I_W2 + 2 * I_NIN + 2 * I_SQ + 4 * I_CW1 + 2 * I_IN3 + 2 * I_SQ + I_ADA + I_PEB;
    int kcount = 0;
#define P0_TAKE(LAY) { if (lsel >= 0 && (LAY) != lsel) continue; const int kc_ = kcount++; if (half >= 0 && (kc_ & 1) != half) continue; }
    for (int it = gw; it < NITEMS; it += NGW) {
        int r = it;
        if (r < I_ADA) {
            P0_TAKE(0)
            const int l = r / 288, rr = r % 288, cgp = rr / 8, kc = rr % 8;
            gemv_item<2>(A.in[2] + (size_t)l * D * 9216, 9216, kc * 128, 128, cgp * 256, A.in[1], D, true, nullptr,
                         (float*)(ws + WS_MODP) + ((size_t)kc * 4 + l) * 2 * 9216, 9216, lane);
            continue; }
        r -= I_ADA;
        if (r < I_PEB) {
            P0_TAKE(0)
            const int jk = r / 16, kc = r % 16;
            gemv_item<1>(A.in[9] + (size_t)jk * 2048 * 256, 256, kc * 128, 128, 0, A.in[8] + (size_t)jk * 2048, 0, false, nullptr, (float*)(ws + WS_CMPBP) + ((size_t)kc * 4 + jk) * 256, 0, lane);
            continue; }
        r -= I_PEB;
        if (r < 8 * I_W1) {
            const int sub = r / I_W1, rr = r % I_W1, nblk = 2 * DFF / 32, kb = rr / nblk, nb = rr % nblk, n0 = 32 * nb;
            P0_TAKE(sub >> 1)
            const int n1 = n0 < DFF ? n0 : n0 - DFF; const int drow = (n1 / 128) * 256 + (n0 < DFF ? 0 : 128) + (n1 % 128);
            transpose_item(A.in[5] + (size_t)sub * D * 2 * DFF, 2 * DFF, 2 * DFF, D, (bf16*)(ws + WS_W1T) + (size_t)sub * 2 * DFF * D, 64 * kb, n0, drow, scr, lane);
            continue; }
        r -= 8 * I_W1;
        if (r < 8 * I_W2) { const int sub = r / I_W2; P0_TAKE(sub >> 1) transpose_plain(A.in[6] + (size_t)sub * DFF * D, DFF, D, D, (bf16*)(ws + WS_W2T) + (size_t)sub * D * DFF, r % I_W2, scr, lane); continue; }
        r -= 8 * I_W2;
        if (r < 2 * I_NIN) { const int sub = r / I_NIN; P0_TAKE(sub * 3) transpose_plain(A.in[7] + (size_t)sub * D * 2608, D, 2608, NSA_PITCH, (bf16*)(ws + WS_NSAIN) + (size_t)sub * NSA_PITCH * D, r % I_NIN, scr, lane); continue; }
        r -= 2 * I_NIN;
        if (r < 2 * I_SQ) { const int sub = r / I_SQ; P0_TAKE(sub * 3) transpose_plain(A.in[11] + (size_t)sub * D * D, D, D, D, (bf16*)(ws + WS_NSAOUT) + (size_t)sub * D * D, r % I_SQ, scr, lane); continue; }
        r -= 2 * I_SQ;
        if (r < 4 * I_CW1) { const int sub = r / I_CW1; P0_TAKE((sub >> 1) * 3) transpose_plain(A.in[9] + (size_t)sub * 2048 * 256, 2048, 256, 256, (bf16*)(ws + WS_CMPW1) + (size_t)sub * 256 * 2048, r % I_CW1, scr, lane); continue; }
        r -= 4 * I_CW1;
        if (r < I_IN3) { P0_TAKE(1) transpose_plain(A.in[12], D, 3 * D, 3 * D, (bf16*)(ws + WS_SBIN), r, scr, lane); continue; }
        r -= I_IN3;
        if (r < I_IN3) { P0_TAKE(2) transpose_plain(A.in[14], D, 3 * D, 3 * D, (bf16*)(ws + WS_DFIN), r, scr, lane); continue; }
        r -= I_IN3;
        if (r < I_SQ) { P0_TAKE(1) transpose_plain(A.in[13], D, D, D, (bf16*)(ws + WS_SBOUT), r, scr, lane); continue; }
        r -= I_SQ;
        P0_TAKE(2)
        transpose_plain(A.in[17], D, D, D, (bf16*)(ws + WS_DFOUT), r, scr, lane);
    }
#undef P0_TAKE
}

__device__ __forceinline__ void p0_reduce(const Args& A, int G, int bid, int tid) {
    unsigned char* ws = A.ws;
    const float* modp = (const float*)(ws + WS_MODP); float* mod = (float*)(ws + WS_MOD);
    const float* cp = (const float*)(ws + WS_CMPBP); float* cb = (float*)(ws + WS_CMPB);
    constexpr int NMOD = 4 * 2 * 9216;
    for (int i = bid * 512 + tid; i < NMOD + 1024; i += G * 512) {
        if (i < NMOD) { const int l = i / (2 * 9216), n = i % 9216; float s = A.in[3][l * 9216 + n];
#pragma unroll
            for (int kc = 0; kc < 8; ++kc) s += modp[(size_t)kc * NMOD + i];
            mod[i] = s; }
        else { const int j = i - NMOD; float s = 0.f;
#pragma unroll
            for (int kc = 0; kc < 16; ++kc) s += cp[kc * 1024 + j];
            cb[j] = s; }
    }
}

__device__ __forceinline__ void row_phase(const float* Xin, const float* Y, float* Xout, bf16* XBout, bf16* HH,
                                          const float* mod_post  , int sidx_post, const float* g_post, float res_w,
                                          const float* mod_pre, int sidx_pre, const float* g_pre, int G, int bid, int wave, int lane) {
    const int gw = bid * NWAVES + wave, NGW = G * NWAVES;
#define RIDX(j) (2 * lane + 128 * ((j) >> 1) + ((j) & 1))
    for (int m = gw; m < M; m += NGW) {
        const int b = m / T;
        const f32x4* xr = (const f32x4*)(Xin + (size_t)m * D);
        f32x4 x[4];
#pragma unroll
        for (int j = 0; j < 4; ++j) x[j] = xr[RIDX(j)];
        if (Y) {
            const f32x4* yr = (const f32x4*)(Y + (size_t)m * D);
            f32x4 y[4]; float s = 0.f;
#pragma unroll
            for (int j = 0; j < 4; ++j) { y[j] = yr[RIDX(j)]; s += (y[j].x * y[j].x + y[j].y * y[j].y) + (y[j].z * y[j].z + y[j].w * y[j].w); }
            const float rstd = rsqrtf(wave_sum(s) * (1.f / D) + EPS) * res_w;
            const float* gate = mod_post + (size_t)b * 9216 + (sidx_post * 3 + 2) * D;
#pragma unroll
            for (int j = 0; j < 4; ++j) { const f32x4 gt = *((const f32x4*)gate + RIDX(j)), gp = *((const f32x4*)g_post + RIDX(j));
                x[j] += gt * gp * (y[j] * rstd); }
        }
        if (XBout) { u32x4* xb = (u32x4*)(XBout + (size_t)m * D) + lane;
#pragma unroll
            for (int q = 0; q < 2; ++q) { u32x4 w; w.x = pg8::cvt_pk_f16(x[2 * q].x, x[2 * q].y); w.y = pg8::cvt_pk_f16(x[2 * q].z, x[2 * q].w);
                w.z = pg8::cvt_pk_f16(x[2 * q + 1].x, x[2 * q + 1].y); w.w = pg8::cvt_pk_f16(x[2 * q + 1].z, x[2 * q + 1].w); xb[64 * q] = w; } }
        if (Xout) { f32x4* xo = (f32x4*)(Xout + (size_t)m * D);
#pragma unroll
            for (int j = 0; j < 4; ++j) xo[RIDX(j)] = x[j]; }
        if (HH) {
            float s = 0.f;
#pragma unroll
            for (int j = 0; j < 4; ++j) s += (x[j].x * x[j].x + x[j].y * x[j].y) + (x[j].z * x[j].z + x[j].w * x[j].w);
            const float rstd = rsqrtf(wave_sum(s) * (1.f / D) + EPS);
            const float* shift = mod_pre + (size_t)b * 9216 + (sidx_pre * 3 + 0) * D; const float* scl = shift + D;
            u32x4* ho = (u32x4*)(HH + (size_t)m * D) + lane;
#pragma unroll
            for (int q = 0; q < 2; ++q) { u32x4 w;
#pragma unroll
                for (int e = 0; e < 2; ++e) { const int j = 2 * q + e;
                    const f32x4 sh = *((const f32x4*)shift + RIDX(j)), sc = *((const f32x4*)scl + RIDX(j)), gp = *((const f32x4*)g_pre + RIDX(j));
                    const f32x4 h = x[j] * rstd * gp * (sc + 1.0f) + sh;
                    if (e == 0) { w.x = pk2(h.x, h.y); w.y = pk2(h.z, h.w); } else { w.z = pk2(h.x, h.y); w.w = pk2(h.z, h.w); } }
                ho[64 * q] = w; }
        }
    }
#undef RIDX
}

constexpr int KP64 = 144;
constexpr int KP128 = 272;
constexpr int TILE64 = 64 * KP64;

__device__ __forceinline__ f32x16 zero16() { f32x16 z; for (int i = 0; i < 16; ++i) z[i] = 0.f; return z; }
#define MFMA32(a, b, c) __builtin_amdgcn_mfma_f32_32x32x16_bf16((a), (b), (c), 0, 0, 0)

__device__ __forceinline__ void qk_tile(f32x16& s0, f32x16& s1, const lds_u8* Kt, int pitch, const bf16x8 (&qf)[4], int r32, int hi) {
    const lds_u8* p = Kt + r32 * pitch + hi * 16;
    s0 = zero16(); s1 = zero16();
#pragma unroll
    for (int ks = 0; ks < 4; ++ks) {
        const bf16x8 a0 = *(const LAS bf16x8*)(p + ks * 32);
        const bf16x8 a1 = *(const LAS bf16x8*)(p + 32 * pitch + ks * 32);
        s0 = MFMA32(a0, qf[ks], s0); s1 = MFMA32(a1, qf[ks], s1);
    }
}
template <int NDB>
__device__ __forceinline__ void pv_tile(f32x16 (&o)[NDB], const lds_u8* Vt, const bf16x8 (&pf)[4], int r32, int hi) {
    const lds_u8* p = Vt + r32 * KP64 + hi * 16;
#pragma unroll
    for (int j = 0; j < 4; ++j) {
        bf16x8 a[NDB];
#pragma unroll
        for (int db = 0; db < NDB; ++db) a[db] = *(const LAS bf16x8*)(p + db * 32 * KP64 + j * 32);
#pragma unroll
        for (int db = 0; db < NDB; ++db) o[db] = MFMA32(a[db], pf[j], o[db]);
    }
}
__device__ __forceinline__ void pack_p(bf16x8 (&pf)[4], const f32x16& p0, const f32x16& p1) {
#pragma unroll
    for (int j = 0; j < 4; ++j) {
        const f32x16& s = (j < 2) ? p0 : p1; const int o = 8 * (j & 1);
        u32x4 w; w.x = pk2(s[o + 0], s[o + 1]); w.y = pk2(s[o + 2], s[o + 3]); w.z = pk2(s[o + 4], s[o + 5]); w.w = pk2(s[o + 6], s[o + 7]);
        pf[j] = __builtin_bit_cast(bf16x8, w);
    }
}
template <int NDB>
__device__ __forceinline__ void softmax_step(f32x16& s0, f32x16& s1, float& m, float& l, f32x16 (&o)[NDB]) {
    float mx = s0[0];
#pragma unroll
    for (int r = 1; r < 16; ++r) mx = fmaxf(mx, s0[r]);
#pragma unroll
    for (int r = 0; r < 16; ++r) mx = fmaxf(mx, s1[r]);
    mx = fmaxf(mx, __shfl_xor(mx, 32));
    const float mn = fmaxf(m, mx), alpha = ex2(m - mn);
    m = mn;
    float sum = 0.f;
#pragma unroll
    for (int r = 0; r < 16; ++r) { s0[r] = ex2(s0[r] - mn); s1[r] = ex2(s1[r] - mn); sum += s0[r] + s1[r]; }
    l = l * alpha + sum;
#pragma unroll
    for (int db = 0; db < NDB; ++db) o[db] *= alpha;
}
__device__ __forceinline__ void st_k64(lds_u8* Kb, u32x4 v, int tid) { *(LAS u32x4*)(Kb + (tid >> 3) * KP64 + (tid & 7) * 16) = v; }
__device__ __forceinline__ void st_vt64(lds_u8* Vb, u32x4 v, int row, int c) {
    lds_u8* p = Vb + row * KP64 + 32 * (c >> 1) + 8 * (c & 1);
    *(LAS u32x2*)p = (u32x2){v.x, v.y}; *(LAS u32x2*)(p + 16) = (u32x2){v.z, v.w};
}

constexpr int KPA64 = 176, KPA128 = 304;
constexpr int TILEA64 = 64 * KPA64;
__device__ __forceinline__ bf16x8 alibi_qfrag(float slope2, int hi) {
    const unsigned h0 = pk2(slope2, 0.f) & 0xffffu; const float f0 = __uint_as_float(h0 << 16);
    const float r1 = slope2 - f0; const unsigned h1 = pk2(r1, 0.f) & 0xffffu; const float f1 = __uint_as_float(h1 << 16);
    const float r2 = r1 - f1; const unsigned h2 = pk2(r2, 0.f) & 0xffffu;
    const unsigned g0 = pk2(64.f * f0, 0.f) & 0xffffu, g1 = pk2(64.f * f1, 0.f) & 0xffffu, g2 = pk2(64.f * __uint_as_float(h2 << 16), 0.f) & 0xffffu;
    u32x4 w; w.x = g0 | (g1 << 16); w.y = g2 | (h0 << 16); w.z = h1 | (h2 << 16); w.w = 0u;
    if (hi) w = (u32x4){0u, 0u, 0u, 0u};
    return __builtin_bit_cast(bf16x8, w);
}
__device__ __forceinline__ void st_kextra(lds_u8* rowp, int pos) {
    const unsigned a = pk2((float)(pos >> 6), 0.f) & 0xffffu, b = pk2((float)(pos & 63), 0.f) & 0xffffu;
    u32x4 w; w.x = a | (a << 16); w.y = a | (b << 16); w.z = b | (b << 16); w.w = 0u;
    *(LAS u32x4*)rowp = w; *(LAS u32x4*)(rowp + 16) = (u32x4){0u, 0u, 0u, 0u};
}
__device__ __forceinline__ void qk_tile5(f32x16& s0, f32x16& s1, const lds_u8* Kt, int pitch, int colB, int extraB, const bf16x8 (&qf)[4], bf16x8 qx, const f32x16& cinit, int r32, int hi) {
    const lds_u8* p = Kt + r32 * pitch + hi * 16;
    {
        const bf16x8 a0 = *(const LAS bf16x8*)(p + colB), a1 = *(const LAS bf16x8*)(p + 32 * pitch + colB);
        s0 = MFMA32(a0, qf[0], cinit); s1 = MFMA32(a1, qf[0], cinit);
    }
#pragma unroll
    for (int ks = 1; ks < 4; ++ks) {
        const bf16x8 a0 = *(const LAS bf16x8*)(p + colB + ks * 32), a1 = *(const LAS bf16x8*)(p + 32 * pitch + colB + ks * 32);
        s0 = MFMA32(a0, qf[ks], s0); s1 = MFMA32(a1, qf[ks], s1);
    }
    {
        const bf16x8 a0 = *(const LAS bf16x8*)(p + extraB), a1 = *(const LAS bf16x8*)(p + 32 * pitch + extraB);
        s0 = MFMA32(a0, qx, s0); s1 = MFMA32(a1, qx, s1);
    }
}
__device__ __forceinline__ f32x16 splat16(float v) { f32x16 z; for (int i = 0; i < 16; ++i) z[i] = v; return z; }
template <int NDB>
__device__ __forceinline__ void softmax_rel(f32x16& s0, f32x16& s1, float& m, f32x16& negm, float& l, f32x16 (&o)[NDB]) {
    float mx = fmaxf(s0[0], s1[0]);
#pragma unroll
    for (int r = 1; r < 16; ++r) mx = fmaxf(fmaxf(mx, s0[r]), s1[r]);
    mx = fmaxf(mx, __shfl_xor(mx, 32));
    if (__any(mx > 0.f)) {
        const float delta = fmaxf(mx, 0.f), alpha = ex2(-delta);
        m += delta; l *= alpha; negm = splat16(-m);
#pragma unroll
        for (int db = 0; db < NDB; ++db) o[db] *= alpha;
#pragma unroll
        for (int r = 0; r < 16; ++r) { s0[r] -= delta; s1[r] -= delta; }
    }
    float sum = 0.f;
#pragma unroll
    for (int r = 0; r < 16; ++r) { s0[r] = ex2(s0[r]); s1[r] = ex2(s1[r]); sum += s0[r] + s1[r]; }
    l += sum;
}

typedef short v4i16_t __attribute__((ext_vector_type(4)));
__device__ __forceinline__ void st_vpiece(lds_u8* Vb, u32x4 v, int krow, int c) {
    *(LAS u32x4*)(Vb + ((c >> 2) * 4 + (krow >> 4)) * 1024 + (krow & 15) * 64 + (c & 3) * 16) = v;
}
template <int NDB>
__device__ __forceinline__ void pv_tile_tr(f32x16 (&o)[NDB], const lds_u8* Vb, const bf16x8 (&pf)[4], int lane, int hi) {
    const lds_u8* vb = Vb + ((lane >> 4) & 1) * 32 + (lane & 3) * 8 + (4 * hi + ((lane & 15) >> 2)) * 64;
#pragma unroll
    for (int j = 0; j < 4; ++j) {
        bf16x8 a[NDB];
#pragma unroll
        for (int db = 0; db < NDB; ++db) {
            const v4i16_t lo = __builtin_amdgcn_ds_read_tr16_b64_v4i16((LAS v4i16_t*)(vb + db * 4096 + j * 1024));
            const v4i16_t h4 = __builtin_amdgcn_ds_read_tr16_b64_v4i16((LAS v4i16_t*)(vb + db * 4096 + j * 1024 + 512));
            a[db] = (bf16x8){lo[0], lo[1], lo[2], lo[3], h4[0], h4[1], h4[2], h4[3]};
        }
#pragma unroll
        for (int db = 0; db < NDB; ++db) o[db] = MFMA32(a[db], pf[j], o[db]);
    }
}

template <int NDB>
__device__ __forceinline__ void vtr_issue(v4i16_t (&vf)[8 * NDB], const lds_u8* Vb, int lane, int hi) {
    const unsigned vb = (unsigned)(size_t)(Vb + ((lane >> 4) & 1) * 32 + (lane & 3) * 8 + (4 * hi + ((lane & 15) >> 2)) * 64);
#pragma unroll
    for (int db = 0; db < NDB; ++db)
#pragma unroll
        for (int j = 0; j < 4; ++j) {
            asm volatile("ds_read_b64_tr_b16 %0, %1 offset:%c2" : "=&v"(vf[(db * 4 + j) * 2]) : "v"(vb), "i"(db * 4096 + j * 1024) : "memory");
            asm volatile("ds_read_b64_tr_b16 %0, %1 offset:%c2" : "=&v"(vf[(db * 4 + j) * 2 + 1]) : "v"(vb), "i"(db * 4096 + j * 1024 + 512) : "memory");
        }
}
template <int NDB>
__device__ __forceinline__ void vtr_mfma(f32x16 (&o)[NDB], const v4i16_t (&vf)[8 * NDB], const bf16x8 (&pf)[4]) {
#pragma unroll
    for (int j = 0; j < 4; ++j)
#pragma unroll
        for (int db = 0; db < NDB; ++db) {
            const v4i16_t lo = vf[(db * 4 + j) * 2], h4 = vf[(db * 4 + j) * 2 + 1];
            const bf16x8 a = (bf16x8){lo[0], lo[1], lo[2], lo[3], h4[0], h4[1], h4[2], h4[3]};
            o[db] = MFMA32(a, pf[j], o[db]);
        }
}
#define LGKM_WAIT_SB() do { asm volatile("s_waitcnt lgkmcnt(0)" ::: "memory"); __builtin_amdgcn_sched_barrier(0); } while (0)

__device__ __forceinline__ float gelu_tanh(float x) {
    const float u = 0.7978845608028654f * (x + 0.044715f * x * x * x);
    const float e = __expf(-2.0f * fabsf(u)); const float th = (1.0f - e) / (1.0f + e);
    return 0.5f * x * (1.0f + (u < 0.f ? -th : th));
}
__device__ __forceinline__ void compress_phase(const bf16* P, const bf16* W1T  , const float* cmpb  , const float* W2  ,
                                               bf16* kcmp, bf16* vcmpT, lds_u8* lds, int G, int bid, int tid) {
    const int wave = tid >> 6, lane = tid & 63, r32 = lane & 31, hi = lane >> 5;
    constexpr int CA = 0, CB = 528 * 128, CBSZ = 256 * 128;
    LAS float* hid = (LAS float*)(lds + CB);
    LAS f32x4* w2l = (LAS f32x4*)(lds + CA);
    for (int u = bid; u < 256; u += G) {
        const int nb = u & 15, g = (u >> 4) & 3, b = (u >> 6) & 1, kv = u >> 7;
        f32x4 w2r[8];
#pragma unroll
        for (int i = 0; i < 8; ++i) w2r[i] = *((const f32x4*)(W2 + (size_t)kv * 256 * 64) + tid + 512 * i);
        const bf16* abase = P + (size_t)b * T * NSA_PITCH + 1024 + kv * 256 + g * 64;
#pragma unroll
        for (int k = 0; k < 9; ++k) { const int id = tid + 512 * k;
            if (id < 528 * 8) { const int t = id >> 3, c = id & 7; int gt = 512 * nb + t; gt = gt < T ? gt : T - 1;
                const u32x4 v = *(const u32x4*)(abase + (size_t)gt * NSA_PITCH + c * 8);
                *(LAS u32x4*)(lds + CA + t * 128 + ((c ^ ((t >> 4) & 7)) * 16)) = v; } }
        const bf16* bbase = W1T + (size_t)kv * 256 * 2048;
        u32x4 brA[4], brB[4];
#define CMP_LOADB(BR, L) do { _Pragma("unroll") for (int k = 0; k < 4; ++k) { const int id = tid + 512 * k; BR[k] = *(const u32x4*)(bbase + (size_t)(id >> 3) * 2048 + (L) * 64 + (id & 7) * 8); } } while (0)
        CMP_LOADB(brA, 0); CMP_LOADB(brB, 1);
        f32x16 acc = zero16();
        const int acol = wave * 32 + r32;
        for (int l0 = 0; l0 < 32; l0 += 2) {
#pragma unroll
            for (int hh = 0; hh < 2; ++hh) { const int l = l0 + hh;
                u32x4 (&br)[4] = hh ? brB : brA;
                lds_u8* Bb = lds + CB + hh * CBSZ;
#pragma unroll
                for (int k = 0; k < 4; ++k) { const int id = tid + 512 * k; const int col = id >> 3, c = id & 7;
                    *(LAS u32x4*)(Bb + col * 128 + ((c ^ ((col >> 1) & 7)) * 16)) = br[k]; }
                __syncthreads();
                if (l + 2 < 32) CMP_LOADB(br, l + 2);
                const int arow = 16 * r32 + l;
                const lds_u8* ap = lds + CA + arow * 128; const int akey = (arow >> 4) & 7;
                const lds_u8* bp = Bb + acol * 128; const int bkey = (acol >> 1) & 7;
#pragma unroll
                for (int ks = 0; ks < 4; ++ks) {
                    const bf16x8 a = *(const LAS bf16x8*)(ap + (((2 * ks + hi) ^ akey) * 16)), bb = *(const LAS bf16x8*)(bp + (((2 * ks + hi) ^ bkey) * 16));
                    acc = MFMA32(a, bb, acc);
                }
            }
        }
        __syncthreads();
        const float bias = cmpb[kv * 256 + wave * 32 + r32];
#pragma unroll
        for (int r = 0; r < 16; ++r) hid[crow(r, hi) * 260 + wave * 32 + r32] = gelu_tanh(acc[r] + bias);
#pragma unroll
        for (int i = 0; i < 8; ++i) w2l[tid + 512 * i] = w2r[i];
        __syncthreads();
        {
            const int row = tid >> 4, d4 = tid & 15;
            f32x4 o = {0.f, 0.f, 0.f, 0.f};
#pragma unroll 8
            for (int j = 0; j < 256; ++j) o += w2l[j * 16 + d4] * hid[row * 260 + j];
            const int nn = nb * 32 + row;
            if (nn >= 511) o = (f32x4){0.f, 0.f, 0.f, 0.f};
            if (kv == 0) { u32x2 w; w.x = pk2(o.x, o.y); w.y = pk2(o.z, o.w); *(u32x2*)(kcmp + ((size_t)b * 512 + nn) * 256 + g * 64 + d4 * 4) = w; }
            else {
#pragma unroll
                for (int j = 0; j < 4; ++j) vcmpT[((size_t)b * 256 + g * 64 + d4 * 4 + j) * 512 + nn] = (bf16)(pk2(o[j], 0.f) & 0xffffu);
            }
        }
        __syncthreads();
    }
}
#define RLX_AGENT __ATOMIC_RELAXED, __HIP_MEMORY_SCOPE_AGENT
#define XB_TMO      128
#define XB_XCNT(j)  (256  + 64 * (j))
#define XB_XSUB(j)  (1280 + 64 * (j))
#define XB_XGEN(j)  (2304 + 64 * (j))
#define XB_TOP      3328
#define XB_TOPGEN   3392
#define XCD_BAR_WORDS 3456
#define XB_SPIN_CAP (1u << 18)

__device__ __forceinline__ unsigned xb_ld(unsigned* p)              { return __hip_atomic_load(p, __ATOMIC_RELAXED, __HIP_MEMORY_SCOPE_AGENT); }
__device__ __forceinline__ unsigned xb_add(unsigned* p, unsigned v) { return __hip_atomic_fetch_add(p, v, __ATOMIC_RELAXED, __HIP_MEMORY_SCOPE_AGENT); }
__device__ __forceinline__ unsigned xb_xcc_id() { return (unsigned)__builtin_amdgcn_s_getreg((3 << 11) | 20) & 0xFu; }
#define XB_SPIN(cond, bar) do { unsigned _sp = 0; while (cond) { __builtin_amdgcn_s_sleep(1); \
    if ((++_sp & 255u) == 0u) { if (xb_ld(&(bar)[XB_TMO])) break; if (_sp > XB_SPIN_CAP) { atomicAdd(&(bar)[XB_TMO], 1u); break; } } } } while (0)

struct XcdBarrier {
    unsigned* bar; unsigned x;
    volatile LAS unsigned* st;
};

__device__ __forceinline__ XcdBarrier xcd_barrier_post(unsigned* bar, volatile LAS unsigned* st) {
    XcdBarrier b; b.bar = bar; b.x = xb_xcc_id(); b.st = st;
    if (threadIdx.x == 0) (void)xb_add(&bar[XB_XCNT(b.x)], 1u);
    return b;
}
__device__ __forceinline__ void xcd_barrier_complete(unsigned* bar, unsigned x, unsigned& nloc, unsigned& nx) {
    const unsigned G = gridDim.x * gridDim.y * gridDim.z;
    unsigned sum, cnt, mine, sp = 0u;
    for (;;) {
        sum = 0u; cnt = 0u; mine = 0u;
#pragma unroll
        for (unsigned j = 0; j < 16; ++j) { const unsigned c = xb_ld(&bar[XB_XCNT(j)]); sum += c; cnt += (c > 0u) ? 1u : 0u; mine = (j == x) ? c : mine; }
        if (sum == G) break;
        __builtin_amdgcn_s_sleep(1);
        if ((++sp & 255u) == 0u) { if (xb_ld(&bar[XB_TMO])) break; if (sp > XB_SPIN_CAP) { atomicAdd(&bar[XB_TMO], 1u); break; } }
    }
    nloc = mine > 0u ? mine : 1u; nx = cnt > 0u ? cnt : 1u;
}

__device__ __forceinline__ void xcd_barrier(const XcdBarrier& b) {
    asm volatile("s_waitcnt vmcnt(0)" ::: "memory");
    __syncthreads();
    if (threadIdx.x == 0) {
        unsigned* bar = b.bar;
        __builtin_amdgcn_s_waitcnt(0);
        unsigned nloc = b.st[0], nx = b.st[1];
        if (nloc == 0u) { xcd_barrier_complete(bar, b.x, nloc, nx); b.st[0] = nloc; b.st[1] = nx; }
        const unsigned old = xb_add(&bar[XB_XSUB(b.x)], 1u);
        const unsigned gen = old / nloc;
        if (old + 1u == (gen + 1u) * nloc) {
            __builtin_amdgcn_fence(__ATOMIC_RELEASE, "agent");
            asm volatile("s_waitcnt vmcnt(0)" ::: "memory");
            const unsigned og = xb_add(&bar[XB_TOP], 1u);
            const unsigned tg = og / nx;
            if (og + 1u == (tg + 1u) * nx) xb_add(&bar[XB_TOPGEN], 1u);
            else XB_SPIN(xb_ld(&bar[XB_TOPGEN]) == tg, bar);
            __builtin_amdgcn_fence(__ATOMIC_ACQUIRE, "agent");
            xb_add(&bar[XB_XGEN(b.x)], 1u);
            asm volatile("s_waitcnt vmcnt(0)" ::: "memory");
        } else {
            XB_SPIN(xb_ld(&bar[XB_XGEN(b.x)]) == gen, bar);
            __builtin_amdgcn_fence(__ATOMIC_ACQUIRE, "agent");
            asm volatile("s_waitcnt vmcnt(0)" ::: "memory");
        }
    }
    __syncthreads();
}
#define TL_BEGIN(LOADV, NT, KPTR, VPTR) { \
    const int _nt = (NT); u32x4 _krA = {0u, 0u, 0u, 0u}, _vrA = {0u, 0u, 0u, 0u}, _krB = {0u, 0u, 0u, 0u}, _vrB = {0u, 0u, 0u, 0u}; \
    if (_nt > 0) { const int ti = 0; (void)ti; _krA = *(const u32x4*)(KPTR); if (LOADV) _vrA = *(const u32x4*)(VPTR); } \
    if (_nt > 1) { const int ti = 1; (void)ti; _krB = *(const u32x4*)(KPTR); if (LOADV) _vrB = *(const u32x4*)(VPTR); } \
    for (int _i = 0; _i < _nt; _i += 2) { \
      _Pragma("unroll") for (int _h = 0; _h < 2; ++_h) { const int _t = _i + _h; if (_t < _nt) { \
        u32x4& _kc = _h ? _krB : _krA; u32x4& _vc = _h ? _vrB : _vrA; \
        lds_u8* Kb = lds + _h * TILE64; lds_u8* Vb = lds + 2 * TILE64 + _h * TILE64; (void)Vb; \
        st_k64(Kb, _kc, tid); if ((LOADV) == 1) st_vt64(Vb, _vc, lrow, lc); else if ((LOADV) == 2) st_vpiece(Vb, _vc, lrow, lc); \
        __syncthreads(); \
          \
        if (_t + 2 < _nt) { const int ti = _t + 2; (void)ti; _kc = *(const u32x4*)(KPTR); if (LOADV) _vc = *(const u32x4*)(VPTR); } \
        { const int ti = _t; (void)ti;
#define TL_END } } } } __syncthreads(); }
template <int NDB>
__device__ __forceinline__ void store_ot(bf16* orow, const f32x16 (&o)[NDB], int hi) {
#pragma unroll
    for (int db = 0; db < NDB; ++db)
#pragma unroll
        for (int jp = 0; jp < 2; ++jp) {
            const int j0 = 2 * jp, j1 = 2 * jp + 1;
            u32x2 g0, g1;
            g0.x = pk2(o[db][4 * j0], o[db][4 * j0 + 1]); g0.y = pk2(o[db][4 * j0 + 2], o[db][4 * j0 + 3]);
            g1.x = pk2(o[db][4 * j1], o[db][4 * j1 + 1]); g1.y = pk2(o[db][4 * j1 + 2], o[db][4 * j1 + 3]);
            const unsigned sx = hi ? g0.x : g1.x, sy = hi ? g0.y : g1.y;
            const unsigned rx = __shfl_xor(sx, 32), ry = __shfl_xor(sy, 32);
            u32x4 w;
            if (hi) { w.x = rx; w.y = ry; w.z = g1.x; w.w = g1.y; } else { w.x = g0.x; w.y = g0.y; w.z = rx; w.w = ry; }
            *(u32x4*)(orow + 32 * db + 8 * (hi ? j1 : j0)) = w;
        }
}

#define CRF(r) ((float)(((r) & 3) + 8 * ((r) >> 2)))
template <int MODE>
__device__ __forceinline__ void bias_mask(f32x16& s0, f32x16& s1, float slope2, int dl, float& a0, float& a1) {
    a0 = NEGB; a1 = NEGB;
#pragma unroll
    for (int r = 0; r < 16; ++r) {
        const int d0 = dl + ((r & 3) + 8 * (r >> 2)), d1 = d0 + 32;
        float v0 = fmaf(slope2, CRF(r), s0[r]), v1 = fmaf(slope2, CRF(r), s1[r]);
        if (MODE == 1) { v0 = d0 <= 0 ? v0 : NEGB; v1 = d1 <= 0 ? v1 : NEGB; }
        if (MODE == 2) { v0 = d0 > -512 ? v0 : NEGB; v1 = d1 > -512 ? v1 : NEGB; }
        s0[r] = v0; s1[r] = v1; a0 = fmaxf(a0, v0); a1 = fmaxf(a1, v1);
    }
}
template <int NDB>
__device__ __forceinline__ void softmax_fast(f32x16& s0, f32x16& s1, float a0, float a1, float base, float c32, bool lane_on, float& m, float& l, f32x16 (&o)[NDB]) {
    float mx = lane_on ? fmaxf(a0, a1 + c32) + base : NEGB;
    mx = fmaxf(mx, __shfl_xor(mx, 32));
    if (__any(mx > m)) {
        const float mn = fmaxf(m, mx), alpha = ex2(m - mn); m = mn; l *= alpha;
#pragma unroll
        for (int db = 0; db < NDB; ++db) o[db] *= alpha;
    }
    const float sub0 = lane_on ? m - base : 1e30f, sub1 = sub0 - c32;
    float sum = 0.f;
#pragma unroll
    for (int r = 0; r < 16; ++r) { s0[r] = ex2(s0[r] - sub0); s1[r] = ex2(s1[r] - sub1); sum += s0[r] + s1[r]; }
    l += sum;
}

constexpr int NSA_LDS_IMP = 4 * TILE64, NSA_LDS_MASK = NSA_LDS_IMP + 64 * 129 * 4, NSA_LDS_LIST = NSA_LDS_MASK + 1024, NSA_LDS_SLOT = NSA_LDS_LIST + 520;
constexpr int NSA_LDS_TOT = 71680;
constexpr float IMP_FIX = 268435456.0f;

__device__ __forceinline__ void nsa_attn_phase(const bf16* P, const bf16* VT, const bf16* kcmp, const bf16* vcmpT, bf16* O, unsigned* ctr, lds_u8* lds, int G, int bid, int tid) {
    const int wave = tid >> 6, lane = tid & 63, r32 = lane & 31, hi = lane >> 5;
    const int lrow = tid >> 3, lc = tid & 7;
    LAS unsigned* imp = (LAS unsigned*)(lds + NSA_LDS_IMP);
    LAS unsigned* masks = (LAS unsigned*)(lds + NSA_LDS_MASK);
    LAS int* blist = (LAS int*)(lds + NSA_LDS_LIST);
    LAS int* slot = (LAS int*)(lds + NSA_LDS_SLOT);
    for (;;) {
        if (tid == 0) *slot = (int)atomicAdd(ctr, 1u);
        __syncthreads();
        const int ui = *slot;
        __syncthreads();
        if (ui >= 1024) break;
        const int qb = 127 - (ui >> 3);
        const int bg = ui & 7, b = bg >> 2, g = bg & 3;
        const int t0 = 64 * qb, ql = 8 * wave + (r32 >> 2), h = 4 * g + (r32 & 3), tq = t0 + ql;
        const size_t mq = (size_t)b * T + tq;
        const float slope2 = ex2(-0.5f * (float)(h + 1)) * LOG2E, c32 = slope2 * 32.0f;
        bf16x8 qf[4];
#pragma unroll
        for (int ks = 0; ks < 4; ++ks) qf[ks] = *(const bf16x8*)(P + mq * NSA_PITCH + h * 64 + 16 * ks + 8 * hi);
        for (int i = tid; i < 64 * 129; i += 512) imp[i] = 0u;
        const int ncmp = (4 * qb + 3) < 511 ? (4 * qb + 3) : 511, ntc = (ncmp + 63) >> 6;
        const bf16* kcb = kcmp + (size_t)b * 512 * 256 + g * 64;
        const bf16* vcb = vcmpT + ((size_t)b * 256 + g * 64) * 512;
        const float slope16 = slope2 * 16.0f;
        float m1 = NEGB, l1 = 0.f;
        TL_BEGIN(0, ntc, kcb + (size_t)(64 * ti + lrow) * 256 + lc * 8, kcb)
                f32x16 s0, s1; qk_tile(s0, s1, Kb, KP64, qf, r32, hi);
                const int dl = 64 * ti + 4 * hi;
                const int nmax = (tq - 31) >> 4;
                float mx = NEGB;
#pragma unroll
                for (int r = 0; r < 16; ++r) { const int n0 = dl + ((r & 3) + 8 * (r >> 2)), n1 = n0 + 32;
                    s0[r] = n0 <= nmax ? fmaf(slope16, CRF(r), s0[r]) : NEGB; s1[r] = n1 <= nmax ? fmaf(slope16, CRF(r), s1[r]) : NEGB;
                    mx = fmaxf(mx, fmaxf(s0[r], s1[r] + 32.0f * slope16)); }
                const float base = slope2 * (float)(16 * dl + 31 - tq);
                mx = fmaxf(mx + base, __shfl_xor(mx + base, 32));
                const float mn = fmaxf(m1, mx); float sum = 0.f;
                const float sub0 = mn - base, sub1 = sub0 - 32.0f * slope16;
#pragma unroll
                for (int r = 0; r < 16; ++r) sum += ex2(s0[r] - sub0) + ex2(s1[r] - sub1);
                l1 = l1 * ex2(m1 - mn) + sum; m1 = mn;
        TL_END
        l1 += __shfl_xor(l1, 32);
        const float inv1 = (tq >= 31) ? 1.0f / l1 : 0.f;
        float g0, g1, g2;
        { const bf16* gp = P + mq * NSA_PITCH + 2560 + 3 * h;
          g0 = 1.0f / (1.0f + __expf(-bf2f(gp[0]))); g1 = 1.0f / (1.0f + __expf(-bf2f(gp[1]))); g2 = 1.0f / (1.0f + __expf(-bf2f(gp[2]))); }
        LAS float* totl = (LAS float*)(lds + NSA_LDS_TOT + wave * 8192) + lane;
        {
            f32x16 oc[2]; oc[0] = zero16(); oc[1] = zero16();
            TL_BEGIN(1, ntc, kcb + (size_t)(64 * ti + lrow) * 256 + lc * 8, vcb + (size_t)lrow * 512 + 64 * ti + lc * 8)
                    f32x16 s0, s1; qk_tile(s0, s1, Kb, KP64, qf, r32, hi);
                    const int dl = 64 * ti + 4 * hi;
                    const int nmax = (tq - 31) >> 4;
                    const float sub0 = m1 - slope2 * (float)(16 * dl + 31 - tq), sub1 = sub0 - 32.0f * slope16;
#pragma unroll
                    for (int r = 0; r < 16; ++r) { const int n0 = dl + ((r & 3) + 8 * (r >> 2)), n1 = n0 + 32;
                        s0[r] = n0 <= nmax ? ex2(fmaf(slope16, CRF(r), s0[r]) - sub0) * inv1 : 0.f; s1[r] = n1 <= nmax ? ex2(fmaf(slope16, CRF(r), s1[r]) - sub1) * inv1 : 0.f; }
#pragma unroll
                    for (int bk = 0; bk < 2; ++bk)
#pragma unroll
                        for (int j = 0; j < 4; ++j) {
                            const f32x16& s = bk ? s1 : s0;
                            const int sb = 16 * ti + 8 * bk + 2 * j + hi;
                            const float gs = (s[4 * j] + s[4 * j + 1]) + (s[4 * j + 2] + s[4 * j + 3]);
                            if (sb <= qb) __hip_atomic_fetch_add(&imp[ql * 129 + sb], (unsigned)(gs * IMP_FIX + 0.5f), __ATOMIC_RELAXED, __HIP_MEMORY_SCOPE_WORKGROUP);
                            if (sb + 1 <= qb) __hip_atomic_fetch_add(&imp[ql * 129 + sb + 1], (unsigned)(s[4 * j + 3] * IMP_FIX + 0.5f), __ATOMIC_RELAXED, __HIP_MEMORY_SCOPE_WORKGROUP);
                        }
                    bf16x8 pf[4]; pack_p(pf, s0, s1); pv_tile<2>(oc, Vb, pf, r32, hi);
            TL_END
#pragma unroll
            for (int db = 0; db < 2; ++db)
#pragma unroll
                for (int r = 0; r < 16; ++r) totl[(db * 16 + r) * 64] = oc[db][r] * g0;
        }
        unsigned mk0, mk1, mk2, mk3; unsigned long long ulo, uhi;
        if (qb < 16) { mk0 = (2u << qb) - 1u; mk1 = mk2 = mk3 = 0u; ulo = mk0; uhi = 0ull; }
        else {
            const int s0i = lane, s1i = lane + 64;
            const bool c0 = s0i >= 1 && s0i <= qb - 2, c1 = s1i <= qb - 2;
            { const int i4 = 0;
                int v0[8], v1[8], thr[8];
#pragma unroll
                for (int k = 0; k < 8; ++k) { const int q = wave * 8 + i4 + k;
                    v0[k] = c0 ? (int)imp[q * 129 + s0i] : -1; v1[k] = c1 ? (int)imp[q * 129 + s1i] : -1; thr[k] = 0; }
#pragma unroll 1
                for (int bit = 30; bit >= 0; --bit) {
                    unsigned long long bm0[8], bm1[8];
#pragma unroll
                    for (int k = 0; k < 8; ++k) { const int cand = thr[k] | (1 << bit); bm0[k] = __ballot(v0[k] >= cand); bm1[k] = __ballot(v1[k] >= cand); }
#pragma unroll
                    for (int k = 0; k < 8; ++k) { const int c = __builtin_popcountll(bm0[k]) + __builtin_popcountll(bm1[k]);
                        thr[k] = c >= 13 ? (thr[k] | (1 << bit)) : thr[k]; }
                }
#pragma unroll
                for (int k = 0; k < 8; ++k) { const int q = wave * 8 + i4 + k;
                    const bool gt0 = v0[k] > thr[k], gt1 = v1[k] > thr[k], eq0 = v0[k] == thr[k], eq1 = v1[k] == thr[k];
                    const int need = 13 - (__builtin_popcountll(__ballot(gt0)) + __builtin_popcountll(__ballot(gt1)));
                    const unsigned long long be0 = __ballot(eq0), be1 = __ballot(eq1), lm = (1ull << lane) - 1ull;
                    const int re0 = __builtin_popcountll(be0 & lm), re1 = __builtin_popcountll(be0) + __builtin_popcountll(be1 & lm);
                    const bool sel0 = gt0 || (eq0 && re0 < need) || s0i == 0 || s0i == qb || s0i == qb - 1;
                    const bool sel1 = gt1 || (eq1 && re1 < need) || s1i == qb || s1i == qb - 1;
                    const unsigned long long b0 = __ballot(sel0), b1 = __ballot(sel1);
                    if (lane == 0) { masks[q * 4 + 0] = (unsigned)b0; masks[q * 4 + 1] = (unsigned)(b0 >> 32); masks[q * 4 + 2] = (unsigned)b1; masks[q * 4 + 3] = (unsigned)(b1 >> 32); } }
            }
            __syncthreads();
            mk0 = masks[ql * 4 + 0]; mk1 = masks[ql * 4 + 1]; mk2 = masks[ql * 4 + 2]; mk3 = masks[ql * 4 + 3];
            unsigned u0 = masks[lane * 4 + 0], u1 = masks[lane * 4 + 1], u2 = masks[lane * 4 + 2], u3 = masks[lane * 4 + 3];
#pragma unroll
            for (int o = 1; o < 64; o <<= 1) { u0 |= __shfl_xor(u0, o); u1 |= __shfl_xor(u1, o); u2 |= __shfl_xor(u2, o); u3 |= __shfl_xor(u3, o); }
            u0 = __builtin_amdgcn_readfirstlane(u0); u1 = __builtin_amdgcn_readfirstlane(u1); u2 = __builtin_amdgcn_readfirstlane(u2); u3 = __builtin_amdgcn_readfirstlane(u3);
            ulo = (unsigned long long)u0 | ((unsigned long long)u1 << 32); uhi = (unsigned long long)u2 | ((unsigned long long)u3 << 32);
        }
        const int nsel = __builtin_popcountll(ulo) + __builtin_popcountll(uhi);
        if (tid < 128) {
            const unsigned long long w = tid < 64 ? ulo : uhi; const int sb = tid & 63;
            if ((w >> sb) & 1ull) blist[__builtin_popcountll(w & ((1ull << sb) - 1ull)) + (tid < 64 ? 0 : __builtin_popcountll(ulo))] = tid;
        }
        __syncthreads();
        {
            f32x16 os[2]; os[0] = zero16(); os[1] = zero16(); float m2 = NEGB, l2 = 0.f;
            const bf16* ksb = P + (size_t)b * T * NSA_PITCH + 1536 + g * 64;
            TL_BEGIN(2, nsel, ksb + (size_t)(64 * blist[ti] + lrow) * NSA_PITCH + lc * 8, ksb + 256 + (size_t)(64 * blist[ti] + lrow) * NSA_PITCH + lc * 8)
                    const int s = blist[ti];
                    const unsigned wsel = s < 32 ? mk0 : (s < 64 ? mk1 : (s < 96 ? mk2 : mk3));
                    const bool selb = (wsel >> (s & 31)) & 1u;
                    if (__any(selb)) {
                        f32x16 s0, s1; qk_tile(s0, s1, Kb, KP64, qf, r32, hi);
                        v4i16_t vf[16]; vtr_issue<2>(vf, Vb, lane, hi);
                        const int dl = 64 * s - tq + 4 * hi; float a0, a1;
                        if (s < qb) bias_mask<0>(s0, s1, slope2, dl, a0, a1); else bias_mask<1>(s0, s1, slope2, dl, a0, a1);
                        softmax_fast<2>(s0, s1, a0, a1, slope2 * (float)dl, c32, selb, m2, l2, os);
                        bf16x8 pf[4]; pack_p(pf, s0, s1);
                        LGKM_WAIT_SB(); vtr_mfma<2>(os, vf, pf);
                    }
            TL_END
            l2 += __shfl_xor(l2, 32);
            const float w = g1 / l2;
#pragma unroll
            for (int db = 0; db < 2; ++db)
#pragma unroll
                for (int r = 0; r < 16; ++r) totl[(db * 16 + r) * 64] += os[db][r] * w;
        }
        {
            f32x16 ow[2]; ow[0] = zero16(); ow[1] = zero16(); float m3 = NEGB, l3 = 0.f;
            const int ntw = (qb < 8 ? qb : 8) + 1;
            const bf16* kwb = P + (size_t)b * T * NSA_PITCH + 2048 + g * 64;
            TL_BEGIN(2, ntw, kwb + (size_t)(64 * (qb - ti) + lrow) * NSA_PITCH + lc * 8, kwb + 256 + (size_t)(64 * (qb - ti) + lrow) * NSA_PITCH + lc * 8)
                    f32x16 s0, s1; qk_tile(s0, s1, Kb, KP64, qf, r32, hi);
                    v4i16_t vf[16]; vtr_issue<2>(vf, Vb, lane, hi);
                    const int dl = 64 * (qb - ti) - tq + 4 * hi; float a0, a1;
                    if (ti == 0) bias_mask<1>(s0, s1, slope2, dl, a0, a1); else if (ti == 8) bias_mask<2>(s0, s1, slope2, dl, a0, a1); else bias_mask<0>(s0, s1, slope2, dl, a0, a1);
                    softmax_fast<2>(s0, s1, a0, a1, slope2 * (float)dl, c32, true, m3, l3, ow);
                    bf16x8 pf[4]; pack_p(pf, s0, s1);
                    LGKM_WAIT_SB(); vtr_mfma<2>(ow, vf, pf);
            TL_END
            l3 += __shfl_xor(l3, 32);
            const float w = g2 / l3;
#pragma unroll
            for (int db = 0; db < 2; ++db)
#pragma unroll
                for (int r = 0; r < 16; ++r) ow[db][r] = totl[(db * 16 + r) * 64] + ow[db][r] * w;
            store_ot<2>(O + mq * D + h * 64, ow, hi);
        }
    }
}

constexpr int SB_LDS_FLAGS = 4 * TILE64;
constexpr float SB_STOP = 152.0f;
__device__ __forceinline__ void sb_attn_phase(const bf16* QK, const bf16* VT, bf16* O, lds_u8* lds, int G, int bid, int tid) {
    const int wave = tid >> 6, lane = tid & 63, r32 = lane & 31, hi = lane >> 5;
    const int lrow = tid >> 3, lc = tid & 7;
    LAS int* flags = (LAS int*)(lds + SB_LDS_FLAGS);
    for (int ui = bid; ui < 1024; ui += G) {
        const int bh = ui & 31, b = bh >> 4, h = bh & 15, qblk = ui >> 5;
        const int t0 = 256 * qblk, tw0 = t0 + 32 * wave, tq = tw0 + r32;
        const size_t mq = (size_t)b * T + tq;
        bf16x8 qf[4];
#pragma unroll
        for (int ks = 0; ks < 4; ++ks) qf[ks] = *(const bf16x8*)(QK + mq * QK_PITCH + h * 64 + 16 * ks + 8 * hi);
        const bf16* kb = QK + (size_t)b * T * QK_PITCH + 1024 + h * 64 + lc * 8;
        const bf16* vb = VT + (size_t)(h * 64 + lrow) * VT_PITCH + (size_t)b * T + lc * 8;
        const int nt = 4 * qblk + 4;
        f32x16 o[2]; o[0] = zero16(); o[1] = zero16();
        float R = 0.f; int done = 0;
        u32x4 kr = *(const u32x4*)(kb + (size_t)(64 * (nt - 1) + lrow) * QK_PITCH), vr = *(const u32x4*)(vb + 64 * (nt - 1));
        for (int i = 0; i < nt; ++i) {
            const int key0 = 64 * (nt - 1 - i);
            lds_u8* Kb = lds + (i & 1) * TILE64; lds_u8* Vb = lds + 2 * TILE64 + (i & 1) * TILE64;
            st_k64(Kb, kr, tid); st_vt64(Vb, vr, lrow, lc);
            if (lane == 0) flags[(i & 1) * 8 + wave] = done;
            __syncthreads();
            int alld = 1;
#pragma unroll
            for (int w = 0; w < 8; ++w) alld &= flags[(i & 1) * 8 + w];
            if (alld) break;
            if (i + 1 < nt) { kr = *(const u32x4*)(kb + (size_t)(key0 - 64 + lrow) * QK_PITCH); vr = *(const u32x4*)(vb + key0 - 64); }
            if (!done && key0 < tw0 + 31) {
                f32x16 s0, s1; qk_tile(s0, s1, Kb, KP64, qf, r32, hi);
                f32x16 sp0, sp1;
                const int db = key0 - tq;
#pragma unroll
                for (int r = 0; r < 16; ++r) { const int d0 = db + crow(r, hi), d1 = d0 + 32;
                    const float z0 = s0[r], z1 = s1[r];
                    sp0[r] = d0 < 0 ? fmaxf(z0, 0.f) + lg2(1.0f + ex2(-fabsf(z0))) : 0.f;
                    sp1[r] = d1 < 0 ? fmaxf(z1, 0.f) + lg2(1.0f + ex2(-fabsf(z1))) : 0.f; }
                float gs[8], pg[8], SP[8];
#pragma unroll
                for (int p = 0; p < 8; ++p) { const f32x16& s = (p < 4) ? sp0 : sp1; const int j = p & 3;
                    gs[p] = (s[4 * j] + s[4 * j + 1]) + (s[4 * j + 2] + s[4 * j + 3]); pg[p] = __shfl_xor(gs[p], 32); }
                float run = 0.f;
#pragma unroll
                for (int p = 7; p >= 0; --p) { SP[p] = run; run += gs[p] + pg[p]; }
#pragma unroll
                for (int p = 0; p < 8; ++p) {
                    const int j = p & 3; const int dbase = db + (p < 4 ? 0 : 32);
                    float exc = R + SP[p] + (hi == 0 ? pg[p] : 0.f);
#pragma unroll
                    for (int e = 3; e >= 0; --e) {
                        const int r = 4 * j + e; const int d = dbase + crow(r, hi);
                        const float z = (p < 4) ? s0[r] : s1[r], sp = (p < 4) ? sp0[r] : sp1[r];
                        const float a = d < 0 ? ex2(z - sp - exc) : 0.f;
                        exc += sp;
                        if (p < 4) s0[r] = a; else s1[r] = a;
                    }
                }
                R += run;
                bf16x8 pf[4]; pack_p(pf, s0, s1); pv_tile<2>(o, Vb, pf, r32, hi);
                done = __all(R > SB_STOP) ? 1 : 0;
            }
        }
        __syncthreads();
        store_ot<2>(O + mq * D + h * 64, o, hi);
    }
}

__device__ __forceinline__ void knorm_phase(const bf16* QK, unsigned* kmax  , int G, int bid, int tid) {
    const int wave = tid >> 6, lane = tid & 63;
    const int gw = bid * NWAVES + wave, NGW = G * NWAVES;
    float best = 0.f; int bcur = -1;
    for (int m = gw; m < M; m += NGW) {
        const int b = m / T;
        if (b != bcur) { if (bcur >= 0 && (lane & 3) == 0) atomicMax(kmax + bcur * 16 + (lane >> 2), __float_as_uint(best)); best = 0.f; bcur = b; }
        const u32x4* kp = (const u32x4*)(QK + (size_t)m * QK_PITCH + 1024 + 16 * lane);
        const u32x4 a = kp[0], c = kp[1]; float s = 0.f;
        const unsigned w[8] = {a.x, a.y, a.z, a.w, c.x, c.y, c.z, c.w};
#pragma unroll
        for (int i = 0; i < 8; ++i) { const float lo = __uint_as_float(w[i] << 16), hi2 = __uint_as_float(w[i] & 0xffff0000u); s += lo * lo + hi2 * hi2; }
        s += __shfl_xor(s, 1); s += __shfl_xor(s, 2);
        best = fmaxf(best, s);
    }
    if (bcur >= 0 && (lane & 3) == 0) atomicMax(kmax + bcur * 16 + (lane >> 2), __float_as_uint(best));
}

constexpr int DF_KT = 64 * KPA128, DF_VT = 128 * KP64, DF_FLAGS = 2 * DF_KT + 2 * DF_VT, DF_SLOT = DF_FLAGS + 64;
__device__ __forceinline__ void diff_attn_phase(const bf16* QK, const bf16* VT, bf16* O, const float* lam, const float* subg, float lam_init, const unsigned* kmaxp, unsigned* ctr,
                                                lds_u8* lds, int G, int bid, int tid) {
    const int wave = tid >> 6, lane = tid & 63, r32 = lane & 31, hi = lane >> 5;
    const float lam_full = __expf(wave_sum(lam[lane] * lam[64 + lane])) - __expf(wave_sum(lam[128 + lane] * lam[192 + lane])) + lam_init;
    LAS float* exch = (LAS float*)lds;
    LAS int* flags = (LAS int*)(lds + DF_FLAGS);
    LAS int* slot = (LAS int*)(lds + DF_SLOT);
    const int x0 = (int)xb_xcc_id() & 7;
    int qk_i = 0, xq = x0;
    for (;;) {
        if (tid == 0) { int got = -1, xs = xq, kk = qk_i;
            for (; kk < 8; ++kk) { xs = (x0 + kk) & 7; const unsigned j = atomicAdd(ctr + xs, 1u); if (j < 128u) { got = (int)j; break; } }
            slot[0] = got; slot[1] = xs; slot[2] = kk; }
        __syncthreads();
        const int ui = slot[0]; xq = slot[1]; qk_i = slot[2];
        __syncthreads();
        if (ui < 0) break;
        const int qblk = 63 - (ui >> 1), b = xq & 1, h = (ui & 1) ? (xq >> 1) : 7 - (xq >> 1);
        const int mm = wave & 1, qsub = wave >> 1, t0 = 128 * qblk, tw0 = t0 + 32 * qsub, tq = tw0 + r32;
        const size_t mq = (size_t)b * T + tq;
        const float slope2 = ex2(-(float)(h + 1)) * LOG2E;
        const bf16x8 qx = alibi_qfrag(slope2, hi);
        bf16x8 qf[4]; float qn = 0.f;
#pragma unroll
        for (int ks = 0; ks < 4; ++ks) { qf[ks] = *(const bf16x8*)(QK + mq * QK_PITCH + h * 128 + mm * 64 + 16 * ks + 8 * hi);
#pragma unroll
            for (int e = 0; e < 8; ++e) { const float v = bf2f((unsigned short)qf[ks][e]); qn += v * v; } }
        qn += __shfl_xor(qn, 32);
        const float qk_bound = sqrtf(qn) * sqrtf(__uint_as_float(kmaxp[b * 16 + h * 2 + mm])) * 1.001f + 0.01f;
        const bf16* kb = QK + (size_t)b * T * QK_PITCH + 1024 + h * 128;
        const bf16* vb = VT + (size_t)(h * 128) * VT_PITCH + (size_t)b * T;
        const int nt = 2 * qblk + 2;
        f32x16 o[4]; o[0] = zero16(); o[1] = zero16(); o[2] = zero16(); o[3] = zero16();
        f32x16 negm = zero16();
        float m = 0.f, l = 0.f; int dead = 0, started = 0;
        u32x4 krA[2], vrA[2], krB[2], vrB[2];
#define DF_LOAD(KR, VR, KEY0) do { _Pragma("unroll") for (int i2 = 0; i2 < 2; ++i2) { const int idx = tid + 512 * i2; \
            KR[i2] = *(const u32x4*)(kb + (size_t)((KEY0) + (idx >> 4)) * QK_PITCH + (idx & 15) * 8); \
            VR[i2] = *(const u32x4*)(vb + (size_t)(idx >> 3) * VT_PITCH + (KEY0) + (idx & 7) * 8); } } while (0)
        DF_LOAD(krA, vrA, 64 * (nt - 1));
        DF_LOAD(krB, vrB, 64 * (nt - 2));
        bool stop = false;
        for (int i = 0; i < nt && !stop; i += 2) {
#pragma unroll
          for (int hh = 0; hh < 2; ++hh) { const int it = i + hh; if (it < nt && !stop) {
            u32x4 (&kr)[2] = hh ? krB : krA; u32x4 (&vr)[2] = hh ? vrB : vrA;
            const int key0 = 64 * (nt - 1 - it);
            lds_u8* Kb = lds + hh * DF_KT; lds_u8* Vb = lds + 2 * DF_KT + hh * DF_VT;
#pragma unroll
            for (int i2 = 0; i2 < 2; ++i2) { const int idx = tid + 512 * i2;
                *(LAS u32x4*)(Kb + (idx >> 4) * KPA128 + (idx & 15) * 16) = kr[i2];
                st_vt64(Vb, vr[i2], idx >> 3, idx & 7); }
            if (tid < 64) st_kextra(Kb + tid * KPA128 + 256, key0 + tid);
            if (started && !dead) {
                const float bound = qk_bound + slope2 * (float)(key0 + 63);
                dead = __all(bound - m < -175.0f) ? 1 : 0;
            }
            if (lane == 0) flags[hh * 8 + wave] = dead;
            __syncthreads();
            int alld = 1;
#pragma unroll
            for (int w = 0; w < 8; ++w) alld &= flags[hh * 8 + w];
            if (alld) { stop = true; }
            else {
            if (it + 2 < nt) DF_LOAD(kr, vr, key0 - 128);
            if (key0 <= tw0 + 31 && !dead) {
                started = 1;
                f32x16 s0, s1; qk_tile5(s0, s1, Kb, KPA128, mm * 128, 256, qf, qx, negm, r32, hi);
                if (key0 + 63 > tw0) {
                    const int dl = key0 - tq + 4 * hi;
#pragma unroll
                    for (int r = 0; r < 16; ++r) { const int d0 = dl + ((r & 3) + 8 * (r >> 2));
                        s0[r] = d0 <= 0 ? s0[r] : NEGB; s1[r] = d0 + 32 <= 0 ? s1[r] : NEGB; }
                }
                softmax_rel<4>(s0, s1, m, negm, l, o);
                bf16x8 pf[4]; pack_p(pf, s0, s1); pv_tile<4>(o, Vb, pf, r32, hi);
            }
            }
          } }
        }
        __syncthreads();
        l += __shfl_xor(l, 32);
        const float inv = 1.0f / l;
        if (mm == 1) {
#pragma unroll
            for (int db = 0; db < 4; ++db)
#pragma unroll
                for (int r = 0; r < 16; ++r) exch[(qsub * 128 + 32 * db + crow(r, hi)) * 33 + r32] = o[db][r] * inv;
        }
        __syncthreads();
        if (mm == 0) {
            float ssq = 0.f;
#pragma unroll
            for (int db = 0; db < 4; ++db)
#pragma unroll
                for (int r = 0; r < 16; ++r) { const float v = o[db][r] * inv - lam_full * exch[(qsub * 128 + 32 * db + crow(r, hi)) * 33 + r32]; o[db][r] = v; ssq += v * v; }
            ssq += __shfl_xor(ssq, 32);
            const float rstd = rsqrtf(ssq * (1.0f / 128.0f) + EPS) * (1.0f - lam_init);
#pragma unroll
            for (int db = 0; db < 4; ++db)
#pragma unroll
                for (int r = 0; r < 16; ++r) o[db][r] *= rstd * subg[32 * db + crow(r, hi)];
            store_ot<4>(O + mq * D + h * 128, o, hi);
        }
        __syncthreads();
    }
}
#ifndef DUP_MASK
#define DUP_MASK 0
#endif
enum StepType { ST_GEMM_SWIGLU = 0, ST_GEMM_F32 = 1, ST_ROW = 2, ST_GEMM_BF16 = 3, ST_COMPRESS = 4, ST_NSA = 5, ST_SB = 6, ST_DIFF = 7, ST_KNORM = 8 };

__global__ void __launch_bounds__(NWAVES * 64, 2) mega_fwd(Args A) {
    extern __shared__ __attribute__((aligned(16))) unsigned char lds_raw[];
    lds_u8* lds = (lds_u8*)lds_raw;
    cg::grid_group grid = cg::this_grid();
    const int wave = __builtin_amdgcn_readfirstlane(threadIdx.x >> 6);
    const int G = gridDim.x, bid = blockIdx.x;
    unsigned char* ws = A.ws;
    const float* modb = (const float*)(ws + WS_MOD);
    bf16* HH = (bf16*)(ws + WS_HH);
    LAS unsigned long long* larg = (LAS unsigned long long*)(lds + LDS_BYTES - 256);
    if (threadIdx.x == 0) { larg[0] = (unsigned long long)A.in[4]; larg[1] = (unsigned long long)A.in[10]; larg[2] = (unsigned long long)A.in[15]; larg[3] = (unsigned long long)A.in[16];
                            larg[4] = (unsigned long long)A.out; larg[5] = (unsigned long long)A.ws; }
#define LARG(T, i) ((T)(((unsigned long long)__builtin_amdgcn_readfirstlane((unsigned)(larg[i] >> 32)) << 32) | (unsigned long long)__builtin_amdgcn_readfirstlane((unsigned)larg[i])))
    bool last_phase = false;
    volatile LAS unsigned* bar_st = (volatile LAS unsigned*)(lds + LDS_BYTES - 64);
    if (threadIdx.x < 2) bar_st[threadIdx.x] = 0u;
    __syncthreads();
    XcdBarrier bar = xcd_barrier_post((unsigned*)(ws + WS_BAR), bar_st);
#define RUN_PH (true)
#define END_PH do { if (!last_phase) { XcdBarrier bb_; bb_.bar = bar.bar; bb_.x = xb_xcc_id(); bb_.st = bar.st; xcd_barrier(bb_); } } while (0)

    if (RUN_PH) { for (int rep = 0; rep < (((DUP_MASK >> 8) & 1) ? 2 : 1); ++rep) p0_prologue(A, lds, bid * NWAVES + wave, G * NWAVES, wave, threadIdx.x & 63, -1, -1); }
    if (A.ph_lo < 0) { asm volatile("s_waitcnt vmcnt(0)" ::: "memory"); __threadfence(); grid.sync(); __threadfence(); }
    END_PH;
    if (RUN_PH) p0_reduce(A, G, bid, threadIdx.x);
    END_PH;
    if (RUN_PH) row_phase(A.in[0], nullptr, nullptr, (bf16*)(ws + WS_XB), HH, nullptr, 0, nullptr, 0.f, modb, 0, A.in[4], G, bid, wave, threadIdx.x & 63);
    END_PH;

#pragma unroll 1
    for (int l = 0; l < DEPTH; ++l) {
        const int kind = l % 3, jn = l / 3;
#pragma unroll 1
        for (int sidx = 0; sidx < 3; ++sidx) {
            const int nsteps = (sidx != 1) ? 2 : (kind == 1 ? 3 : 4);
#pragma unroll 1
            for (int st = 0; st < nsteps; ++st) {
                int type;
                if (st == nsteps - 1) type = ST_GEMM_F32;
                else if (st == 0) type = (sidx != 1) ? ST_GEMM_SWIGLU : ST_GEMM_BF16;
                else if (kind == 0) type = (st == 1) ? ST_COMPRESS : ST_NSA;
                else if (kind == 1) type = ST_SB;
                else type = (st == 1) ? ST_KNORM : ST_DIFF;
                last_phase = (l == DEPTH - 1 && sidx == 2 && st == nsteps - 1);
#if DUP_MASK
#pragma unroll 1
                for (int rep = 0; rep < (((DUP_MASK >> type) & 1) ? 2 : 1); ++rep)
#define REP_IDX rep
#else
#define REP_IDX 0
#endif
                {
                    int tid = threadIdx.x; asm volatile("" : "+v"(tid));
                    unsigned char* ws = A.ws; float* xout = A.out; const float* norm_g = A.in[4];
                    const float* modb = (const float*)(ws + WS_MOD);
                    bf16* HH = (bf16*)(ws + WS_HH); bf16* Hb = (bf16*)(ws + WS_H); bf16* VT = (bf16*)(ws + WS_VT); bf16* Ob = (bf16*)(ws + WS_O);
                    bf16* kcmp = (bf16*)(ws + WS_KCMP); bf16* vcmpT = (bf16*)(ws + WS_VCMPT);
                    if (type == ST_GEMM_SWIGLU) {
                        const int f = sidx >> 1;
                        pg8::Gemm g{HH, (const bf16*)(ws + WS_W1T) + (size_t)(l * 2 + f) * 2 * DFF * D, M, 2 * DFF, D};
                        pg8::StaticOrder S; S.init(M, 2 * DFF, G, bid);
                        pg8::EpiSwiglu E{Hb, DFF};
                        pg8::gemm_phase<pg8::EpiSwiglu, pg8::StaticOrder, true, true>(lds, g, S, E);
                    } else if (type == ST_GEMM_F32) {
                        pg8::StaticOrder S; S.init(M, D, G, bid);
                        const int l2 = sidx < 2 ? l : l + 1, s2 = sidx < 2 ? sidx + 1 : 0;
                        const bool has_next = l2 < DEPTH;
                        const int lq = has_next ? l2 : 0;
                        int sv = sidx; asm volatile("" : "+s"(sv));
                        pg8::EpiNormResNorm E{uni_ptr((bf16*)(ws + WS_XB)), uni_ptr(has_next ? (float*)nullptr : xout), uni_ptr(has_next ? HH : (bf16*)nullptr), uni_ptr(modb + (size_t)l * 2 * 9216 + (sidx * 3 + 2) * D), uni_ptr(norm_g + (size_t)(l * 6 + 2 * sidx + 1) * D), uni_f(sv == 1 ? 1.0f : 0.5f),
                                              uni_ptr(modb + (size_t)lq * 2 * 9216 + (s2 * 3) * D), uni_ptr(norm_g + (size_t)(lq * 6 + 2 * s2) * D),
                                              uni_ptr((float*)(ws + WS_XSLOT)), uni_ptr((unsigned*)(ws + WS_PCNT)), uni_u(64u * (unsigned)(l * 3 + sidx) + 32u)};
                        const bf16* Ap; const bf16* Bp; int Kg;
                        if (sidx != 1) { Ap = Hb; Bp = (const bf16*)(ws + WS_W2T) + (size_t)(l * 2 + (sidx >> 1)) * D * DFF; Kg = DFF; }
                        else { Ap = Ob; Kg = D; Bp = kind == 0 ? (const bf16*)(ws + WS_NSAOUT) + (size_t)jn * D * D : (kind == 1 ? (const bf16*)(ws + WS_SBOUT) : (const bf16*)(ws + WS_DFOUT)); }
                        pg8::Gemm g{Ap, Bp, M, D, Kg};
                        pg8::gemm_phase<pg8::EpiNormResNorm, pg8::StaticOrder, false, true>(lds, g, S, E);
                    } else if (type == ST_GEMM_BF16) {
                        const bf16* Win = kind == 0 ? (const bf16*)(ws + WS_NSAIN) + (size_t)jn * NSA_PITCH * D : (kind == 1 ? (const bf16*)(ws + WS_SBIN) : (const bf16*)(ws + WS_DFIN));
                        const int nsub = kind == 0 ? 1 : 2;
#pragma unroll 1
                        for (int sg = 0; sg < nsub; ++sg) {
                            const bf16* Ap; const bf16* Bp; int Mg, Ng, ldc, qcols; bf16* Op;
                            if (sg == 0) { Ap = HH; Bp = Win; Mg = M; Ng = kind == 0 ? NSA_PITCH : 2048; Op = Hb; ldc = kind == 0 ? NSA_PITCH : QK_PITCH; qcols = 1024; }
                            else if (kind == 0) { Ap = Win + (size_t)(sg == 1 ? 1792 : 2304) * D; Bp = HH; Mg = 256; Ng = M; Op = VT + (size_t)(sg == 1 ? 0 : 256) * M; ldc = M; qcols = 0; }
                            else { Ap = Win + (size_t)2048 * D; Bp = HH; Mg = 1024; Ng = M; Op = VT; ldc = VT_PITCH; qcols = 0; }
                            pg8::Gemm g{Ap, Bp, Mg, Ng, D};
                            pg8::StaticOrder S; S.init(Mg, Ng, G, bid);
                            pg8::EpiBf16 E{Op, ldc, qcols, QSCALE};
                            pg8::gemm_phase<pg8::EpiBf16, pg8::StaticOrder, true, true>(lds, g, S, E);
                        }
                    } else if (type == ST_COMPRESS) {
                        compress_phase(Hb, (const bf16*)(ws + WS_CMPW1) + (size_t)jn * 2 * 256 * 2048, (const float*)(ws + WS_CMPB) + jn * 512,
                                       A.in[10] + (size_t)jn * 2 * 256 * 64, kcmp, vcmpT, lds, G, bid, tid);
                    } else if (type == ST_NSA) {
                        nsa_attn_phase(Hb, VT, kcmp, vcmpT, Ob, (unsigned*)(ws + WS_CTR) + 64 * l + 16 * REP_IDX, lds, G, bid, tid);
                    } else if (type == ST_SB) {
                        sb_attn_phase(Hb, VT, Ob, lds, G, bid, tid);
                    } else if (type == ST_DIFF) {
                        int lv = l; asm volatile("" : "+s"(lv));
                        const float lam_init = 0.8f - 0.6f * __expf(-0.3f * (float)lv);
                        diff_attn_phase(Hb, VT, Ob, A.in[15], A.in[16], lam_init, (const unsigned*)(ws + WS_KMAX), (unsigned*)(ws + WS_CTR) + 64 * l + 16 * REP_IDX, lds, G, bid, tid);
                    } else if (type == ST_KNORM) {
                        knorm_phase(Hb, (unsigned*)(ws + WS_KMAX), G, bid, tid);
                    }
                }
                END_PH;
            }
        }
    }
}

extern "C" void kernel_launch(void* const* d_in, const int* in_sizes, int n_in, void* d_out, int out_size, void* d_ws, size_t ws_size, hipStream_t stream) {
    static int grid = 0;
    if (grid == 0) {
        if (n_in != 18 || out_size != M * D || ws_size < WS_END) { fprintf(stderr, "kernel_launch: unexpected shapes (n_in %d out %d ws %zu)\n", n_in, out_size, ws_size); grid = -1; return; }
        int dev = 0, cus = 0, per_cu = 0;
        hipGetDevice(&dev);
        hipDeviceGetAttribute(&cus, hipDeviceAttributeMultiprocessorCount, dev);
        hipFuncSetAttribute((const void*)mega_fwd, hipFuncAttributeMaxDynamicSharedMemorySize, LDS_BYTES);
        hipOccupancyMaxActiveBlocksPerMultiprocessor(&per_cu, (const void*)mega_fwd, NWAVES * 64, LDS_BYTES);
        if (per_cu < 1) { fprintf(stderr, "kernel_launch: occupancy query says %d blocks per CU\n", per_cu); per_cu = 1; }
        (void)hipGetLastError();
        grid = cus * per_cu;
    }
    if (grid < 0) return;
    hipMemsetAsync((char*)d_ws + WS_BAR, 0, 64 * 1024, stream);
    Args a{};
    for (int i = 0; i < 18; ++i) a.in[i] = (const float*)d_in[i];
    a.out = (float*)d_out; a.ws = (unsigned char*)d_ws; a.ph_lo = 0; a.ph_hi = 1 << 20;
    void* args[] = {&a};
    hipError_t e = hipLaunchCooperativeKernel((const void*)mega_fwd, dim3(grid), dim3(NWAVES * 64), args, LDS_BYTES, stream);
    if (e != hipSuccess) fprintf(stderr, "cooperative launch failed: %s (grid %d)\n", hipGetErrorString(e), grid);
}
```
